# Optimizing an MI355X kernel written in HIP

```python
import math
import jax, jax.numpy as jnp
from jax import lax
import numpy as np

D_MODEL = 2048
BATCH = 4
SEQ = 2048
DEPTH = 1

CHUNK = 64
Q_BLOCK = 128
EPS = 1e-6
MIX_WIDTH = D_MODEL
DA_WIDTH = MIX_WIDTH // 2
DA_V_DIM = 128
DA_QK_DIM = DA_V_DIM // 2
DA_HEADS = DA_WIDTH // DA_V_DIM
GLA_WIDTH = MIX_WIDTH - DA_WIDTH
GLA_HEADS = 4
GLA_DV = GLA_WIDTH // GLA_HEADS
GLA_DK = GLA_DV // 2
GLA_GATE_RANK = 16
GLA_TAU = 16.0
N_EXPERTS = 32
TOP_K = 4
D_FF = D_MODEL
SWIGLU_LIMIT = 7.0
SWIGLU_ALPHA = 1.702
SPLITS = (DA_HEADS * 2 * DA_QK_DIM, DA_HEADS * 2 * DA_QK_DIM, DA_HEADS * DA_V_DIM,
          GLA_HEADS * GLA_DK, GLA_HEADS * GLA_DK, GLA_HEADS * GLA_DV, GLA_HEADS * GLA_DV,
          GLA_GATE_RANK)
IN_COLS = sum(SPLITS)

kernel_name = 'hybrid_diffattn_gla_moe_block'


def rms_norm(x, w):
    xf = x.astype(jnp.float32)
    y = xf * lax.rsqrt(jnp.mean(xf * xf, axis=-1, keepdims=True) + EPS)
    return (y * w).astype(x.dtype)


def split_cols(y):
    idx = np.cumsum(SPLITS)[:-1].tolist()
    return jnp.split(y, idx, axis=-1)


def diff_attention(q, k, v, q_norm_w, k_norm_w, lam, subln_w, lambda_init):
    B, S, H, _, dq = q.shape
    dv = v.shape[-1]
    q = rms_norm(q, q_norm_w) * (dq ** -0.5)
    k = rms_norm(k, k_norm_w)
    nb = S // Q_BLOCK
    qb = q.reshape(B, nb, Q_BLOCK, H, 2, dq).transpose(1, 0, 2, 3, 4, 5)
    key_chunk = jnp.arange(S) // CHUNK

    def block(args):
        qi, bi = args
        scores = jnp.einsum('bqhmd,bkhmd->bhmqk', qi, k).astype(jnp.float32)
        q_chunk = (bi * Q_BLOCK + jnp.arange(Q_BLOCK)) // CHUNK
        mask = key_chunk[None, :] <= q_chunk[:, None]
        scores = jnp.where(mask[None, None, None], scores, -jnp.inf)
        p = jax.nn.softmax(scores, axis=-1)
        attn = p[:, :, 0] - lam * p[:, :, 1]
        return jnp.einsum('bhqk,bkhd->bqhd', attn.astype(v.dtype), v)

    o = lax.map(block, (qb, jnp.arange(nb)))
    o = o.transpose(1, 0, 2, 3, 4).reshape(B, S, H, dv)
    o = rms_norm(o, subln_w) * (1.0 - lambda_init)
    return o.reshape(B, S, H * dv)


def gla(q, k, v, log_g, r, norm_w):
    B, S, H, dk = q.shape
    dv = v.shape[-1]
    nc = S // CHUNK

    def to_chunks(t):
        return t.reshape(B, nc, CHUNK, H, t.shape[-1]).transpose(1, 0, 3, 2, 4)

    causal = jnp.tril(jnp.ones((CHUNK, CHUNK), dtype=bool))

    def step(state, inp):
        qc, kc, vc, gc = inp
        b = jnp.cumsum(gc.astype(jnp.float32), axis=2)
        o_inter = jnp.einsum('bhcd,bhde->bhce', qc * jnp.exp(b), state)
        diff = b[:, :, :, None, :] - b[:, :, None, :, :]
        decay = jnp.exp(jnp.where(causal[None, None, :, :, None], diff, -jnp.inf))
        A = jnp.einsum('bhid,bhjd,bhijd->bhij', qc, kc, decay)
        o_intra = jnp.einsum('bhij,bhje->bhie', A, vc)
        b_last = b[:, :, -1:, :]
        state = jnp.exp(b_last[:, :, 0, :])[..., None] * state + jnp.einsum(
            'bhjd,bhje->bhde', kc * jnp.exp(b_last - b), vc)
        return state, o_inter + o_intra

    state0 = jnp.zeros((B, H, dk, dv), jnp.float32)
    xs = (to_chunks(q * (dk ** -0.5)), to_chunks(k), to_chunks(v), to_chunks(log_g))
    _, o = lax.scan(step, state0, xs)
    o = o.transpose(1, 0, 3, 2, 4).reshape(B, S, H, dv).astype(v.dtype)
    o = rms_norm(o, norm_w) * jax.nn.silu(r)
    return o.reshape(B, S, H * dv)


def moe(h, router_w, router_b, w_gate, b_gate, w_up, b_up, w_down, b_down):
    B, S, D = h.shape
    t = h.reshape(B * S, D)
    logits = (t @ router_w + router_b).astype(jnp.float32)
    top_vals, top_idx = lax.top_k(logits, TOP_K)
    top_w = jax.nn.softmax(top_vals, axis=-1)
    comb = jnp.einsum('tk,tke->te', top_w, jax.nn.one_hot(top_idx, N_EXPERTS, dtype=jnp.float32))
    y = jnp.zeros((B * S, D), jnp.float32)
    for e in range(N_EXPERTS):
        gate = jnp.minimum(t @ w_gate[e] + b_gate[e], SWIGLU_LIMIT)
        up = jnp.clip(t @ w_up[e] + b_up[e], -SWIGLU_LIMIT, SWIGLU_LIMIT)
        act = (up + 1.0) * gate * jax.nn.sigmoid(SWIGLU_ALPHA * gate)
        y = y + comb[:, e:e + 1] * (act @ w_down[e] + b_down[e])
    return y.reshape(B, S, D).astype(h.dtype)


def setup_inputs(seed: int = 0) -> dict:
    key = jax.random.key(seed)
    ks = jax.random.split(key, 24)
    f32 = jnp.float32

    def nrm(k, shape, scale):
        return jax.random.normal(k, shape, f32) * scale

    def gain(k, shape):
        return 1.0 + 0.05 * jax.random.normal(k, shape, f32)

    L = DEPTH
    return {
        'x': nrm(ks[0], (BATCH, SEQ, D_MODEL), 1.0),
        'attn_norm_w': gain(ks[1], (L, D_MODEL)),
        'w_in': nrm(ks[2], (L, D_MODEL, IN_COLS), D_MODEL ** -0.5),
        'da_q_norm_w': gain(ks[3], (L, DA_QK_DIM)),
        'da_k_norm_w': gain(ks[4], (L, DA_QK_DIM)),
        'da_lambda_q1': nrm(ks[5], (L, DA_QK_DIM), 0.1),
        'da_lambda_k1': nrm(ks[6], (L, DA_QK_DIM), 0.1),
        'da_lambda_q2': nrm(ks[7], (L, DA_QK_DIM), 0.1),
        'da_lambda_k2': nrm(ks[8], (L, DA_QK_DIM), 0.1),
        'da_subln_w': gain(ks[9], (L, DA_V_DIM)),
        'gla_gate_up_w': nrm(ks[10], (L, GLA_GATE_RANK, GLA_HEADS * GLA_DK), GLA_GATE_RANK ** -0.5),
        'gla_gate_up_b': nrm(ks[11], (L, GLA_HEADS * GLA_DK), 0.1),
        'gla_norm_w': gain(ks[12], (L, GLA_DV)),
        'w_out': nrm(ks[13], (L, MIX_WIDTH, D_MODEL), MIX_WIDTH ** -0.5),
        'ffn_norm_w': gain(ks[14], (L, D_MODEL)),
        'router_w': nrm(ks[15], (L, D_MODEL, N_EXPERTS), D_MODEL ** -0.5),
        'router_b': nrm(ks[16], (L, N_EXPERTS), 0.01),
        'exp_w_gate': nrm(ks[17], (L, N_EXPERTS, D_MODEL, D_FF), D_MODEL ** -0.5),
        'exp_b_gate': nrm(ks[18], (L, N_EXPERTS, D_FF), 0.02),
        'exp_w_up': nrm(ks[19], (L, N_EXPERTS, D_MODEL, D_FF), D_MODEL ** -0.5),
        'exp_b_up': nrm(ks[20], (L, N_EXPERTS, D_FF), 0.02),
        'exp_w_down': nrm(ks[21], (L, N_EXPERTS, D_FF, D_MODEL), D_FF ** -0.5),
        'exp_b_down': nrm(ks[22], (L, N_EXPERTS, D_MODEL), 0.02),
    }


def reference(x, attn_norm_w, w_in, da_q_norm_w, da_k_norm_w, da_lambda_q1, da_lambda_k1,
              da_lambda_q2, da_lambda_k2, da_subln_w, gla_gate_up_w, gla_gate_up_b, gla_norm_w,
              w_out, ffn_norm_w, router_w, router_b, exp_w_gate, exp_b_gate, exp_w_up, exp_b_up,
              exp_w_down, exp_b_down):
    B, S, _ = x.shape
    h = x
    for l in range(DEPTH):
        lambda_init = 0.8 - 0.6 * math.exp(-0.3 * l)
        hn = rms_norm(h, attn_norm_w[l])
        proj = jnp.einsum('bsd,dp->bsp', hn, w_in[l])
        da_q, da_k, da_v, g_q, g_k, g_v, g_r, g_down = split_cols(proj)
        lam = (jnp.exp(jnp.sum(da_lambda_q1[l].astype(jnp.float32) * da_lambda_k1[l]))
               - jnp.exp(jnp.sum(da_lambda_q2[l].astype(jnp.float32) * da_lambda_k2[l]))
               + lambda_init)
        out_a = diff_attention(da_q.reshape(B, S, DA_HEADS, 2, DA_QK_DIM),
                               da_k.reshape(B, S, DA_HEADS, 2, DA_QK_DIM),
                               da_v.reshape(B, S, DA_HEADS, DA_V_DIM),
                               da_q_norm_w[l], da_k_norm_w[l], lam, da_subln_w[l], lambda_init)
        log_g = jax.nn.log_sigmoid((g_down @ gla_gate_up_w[l] + gla_gate_up_b[l]).astype(jnp.float32)) / GLA_TAU
        out_b = gla(g_q.reshape(B, S, GLA_HEADS, GLA_DK),
                    g_k.reshape(B, S, GLA_HEADS, GLA_DK),
                    g_v.reshape(B, S, GLA_HEADS, GLA_DV),
                    log_g.reshape(B, S, GLA_HEADS, GLA_DK),
                    g_r.reshape(B, S, GLA_HEADS, GLA_DV),
                    gla_norm_w[l])
        mix = jnp.concatenate([out_a, out_b], axis=-1)
        h = h + jnp.einsum('bsm,md->bsd', mix, w_out[l])
        h = h + moe(rms_norm(h, ffn_norm_w[l]), router_w[l], router_b[l], exp_w_gate[l], exp_b_gate[l],
                    exp_w_up[l], exp_b_up[l], exp_w_down[l], exp_b_down[l])
    return h
```

```cpp
#include <hip/hip_runtime.h>
#include <stdint.h>
#include <stdio.h>

#ifndef FUSED
#define FUSED 1
#endif
#define PROBE 0

#define LAS __attribute__((address_space(3)))
typedef unsigned short bf16_t;
typedef short bf16x8 __attribute__((ext_vector_type(8)));
typedef short s16x4 __attribute__((ext_vector_type(4)));
typedef float f32x4 __attribute__((ext_vector_type(4)));
typedef float f32x16 __attribute__((ext_vector_type(16)));
typedef unsigned u32x4 __attribute__((ext_vector_type(4)));
typedef unsigned u32x2 __attribute__((ext_vector_type(2)));

constexpr int T_TOK = 8192, DM = 2048, NP = 6144, LDW = 6160, SEQ = 2048;
constexpr int NEXP = 32, CAP = 8192;
constexpr int LDS_BYTES = 147456;
constexpr int LDS_PAIR = 131072;
constexpr int LDS_MISC = 131072 + 1024;
constexpr int CW_CNT = 3456, CW_QHEAD = 3520, CW_TMO = 3712, CW_DONE = 4096;
constexpr int CTL_BYTES = (4096 + 32 * 32 * 16) * 4;

__device__ __forceinline__ unsigned cvt_pk_bf16(float lo, float hi) { unsigned r; asm("v_cvt_pk_bf16_f32 %0, %1, %2" : "=v"(r) : "v"(lo), "v"(hi)); return r; }
__device__ __forceinline__ float bf2f(bf16_t b) { return __uint_as_float(((unsigned)b) << 16); }
__device__ __forceinline__ float bflo(unsigned w) { return __uint_as_float(w << 16); }
__device__ __forceinline__ float bfhi(unsigned w) { return __uint_as_float(w & 0xffff0000u); }
__device__ __forceinline__ bf16_t f2bf(float f) { return (bf16_t)(cvt_pk_bf16(f, 0.f) & 0xffffu); }
__device__ __forceinline__ float wave_sum(float v) {
#pragma unroll
  for (int o = 32; o >= 1; o >>= 1) v += __shfl_xor(v, o);
  return v;
}

typedef __bf16 cbf2 __attribute__((ext_vector_type(2)));
typedef float cf2 __attribute__((ext_vector_type(2)));
__device__ __forceinline__ unsigned pkc(float a, float b) { cf2 v = {a, b}; cbf2 r = __builtin_convertvector(v, cbf2); return *reinterpret_cast<unsigned*>(&r); }
__device__ __forceinline__ void quad_pair16(const u32x2 w0, const u32x2 w1, const int odd, u32x4& out) {
  const unsigned sx = odd ? w0.x : w1.x, sy = odd ? w0.y : w1.y;
  const unsigned rx = (unsigned)__shfl_xor((int)sx, 16), ry = (unsigned)__shfl_xor((int)sy, 16);
  out = odd ? (u32x4){rx, ry, w1.x, w1.y} : (u32x4){w0.x, w0.y, rx, ry};
}
__device__ __forceinline__ int otid() { int t = threadIdx.x; asm volatile("" : "+v"(t)); return t; }
#define XB_TMO      128
#define XB_XCNT(j)  (256  + 64 * (j))
#define XB_XSUB(j)  (1280 + 64 * (j))
#define XB_XGEN(j)  (2304 + 64 * (j))
#define XB_TOP      3328
#define XB_TOPGEN   3392
#define XCD_BAR_WORDS 3456
#define XB_SPIN_CAP (1u << 18)
__device__ __forceinline__ unsigned xb_ld(unsigned* p)              { return __hip_atomic_load(p, __ATOMIC_RELAXED, __HIP_MEMORY_SCOPE_AGENT); }
__device__ __forceinline__ unsigned xb_add(unsigned* p, unsigned v) { return __hip_atomic_fetch_add(p, v, __ATOMIC_RELAXED, __HIP_MEMORY_SCOPE_AGENT); }
__device__ __forceinline__ unsigned xb_xcc_id() { return (unsigned)__builtin_amdgcn_s_getreg((3 << 11) | 20) & 0xFu; }
#define XB_SPIN(cond, bar) do { unsigned _sp = 0; while (cond) { __builtin_amdgcn_s_sleep(1); \
    if ((++_sp & 255u) == 0u) { if (xb_ld(&(bar)[XB_TMO])) break; if (_sp > XB_SPIN_CAP) { atomicAdd(&(bar)[XB_TMO], 1u); break; } } } } while (0)
struct XcdBarrier { unsigned* bar; unsigned x; volatile LAS unsigned* st; };
__device__ __forceinline__ XcdBarrier xcd_barrier_post(unsigned* bar, volatile LAS unsigned* st) {
    XcdBarrier b; b.bar = bar; b.x = xb_xcc_id(); b.st = st;
    if (threadIdx.x == 0) (void)xb_add(&bar[XB_XCNT(b.x)], 1u);
    return b;
}
__device__ __forceinline__ void xcd_barrier_complete(unsigned* bar, unsigned x, unsigned& nloc, unsigned& nx) {
    const unsigned G = gridDim.x * gridDim.y * gridDim.z;
    unsigned sum, cnt, mine, sp = 0u;
    for (;;) {
        sum = 0u; cnt = 0u; mine = 0u;
#pragma unroll
        for (unsigned j = 0; j < 16; ++j) { const unsigned c = xb_ld(&bar[XB_XCNT(j)]); sum += c; cnt += (c > 0u) ? 1u : 0u; mine = (j == x) ? c : mine; }
        if (sum == G) break;
        __builtin_amdgcn_s_sleep(1);
        if ((++sp & 255u) == 0u) { if (xb_ld(&bar[XB_TMO])) break; if (sp > XB_SPIN_CAP) { atomicAdd(&bar[XB_TMO], 1u); break; } }
    }
    nloc = mine > 0u ? mine : 1u; nx = cnt > 0u ? cnt : 1u;
}
__device__ __forceinline__ void xcd_barrier(const XcdBarrier& b) {
    asm volatile("s_waitcnt vmcnt(0)" ::: "memory");
    __syncthreads();
    if (threadIdx.x == 0) {
        unsigned* bar = b.bar;
        __builtin_amdgcn_s_waitcnt(0);
        unsigned nloc = b.st[0], nx = b.st[1];
        if (nloc == 0u) { xcd_barrier_complete(bar, b.x, nloc, nx); b.st[0] = nloc; b.st[1] = nx; }
        const unsigned old = xb_add(&bar[XB_XSUB(b.x)], 1u);
        const unsigned gen = old / nloc;
        if (old + 1u == (gen + 1u) * nloc) {
            __builtin_amdgcn_fence(__ATOMIC_RELEASE, "agent");
            asm volatile("s_waitcnt vmcnt(0)" ::: "memory");
            const unsigned og = xb_add(&bar[XB_TOP], 1u);
            const unsigned tg = og / nx;
            if (og + 1u == (tg + 1u) * nx) xb_add(&bar[XB_TOPGEN], 1u);
            else XB_SPIN(xb_ld(&bar[XB_TOPGEN]) == tg, bar);
            __builtin_amdgcn_fence(__ATOMIC_ACQUIRE, "agent");
            xb_add(&bar[XB_XGEN(b.x)], 1u);
            asm volatile("s_waitcnt vmcnt(0)" ::: "memory");
        } else {
            XB_SPIN(xb_ld(&bar[XB_XGEN(b.x)]) == gen, bar);
            __builtin_amdgcn_fence(__ATOMIC_ACQUIRE, "agent");
            asm volatile("s_waitcnt vmcnt(0)" ::: "memory");
        }
    }
    __syncthreads();
}

struct Params {
  const float *x, *attn_norm_w, *w_in, *q_norm_w, *k_norm_w, *lq1, *lk1, *lq2, *lk2, *subln_w, *gate_up_w, *gate_up_b, *gla_norm_w,
              *w_out, *ffn_norm_w, *router_w, *router_b, *wg, *bg, *wu, *bu, *wd, *bd;
  float* out;
  unsigned* bar; unsigned* cnt;
  bf16_t *wt_in, *wt_out, *wgd_hi, *wgd_lo, *hn, *proj, *mix, *qtil, *st, *tb, *wr_hi, *wr_lo, *act, *y;
  float *gd, *decay, *pw; bf16_t *oib, *Ub;
  int* list;
};

constexpr int BM = 256, BK = 64, HALF = 128, HTB = HALF * BK * 2, KDIM = 2048, NKT = KDIM / BK;
__device__ __forceinline__ int lds_byte(int r, int c) { const int st = (r >> 4) * 2 + (c >> 5), rr = r & 15, cc = c & 31, ob = rr * 64 + cc * 2; return st * 1024 + (ob ^ (((ob >> 9) & 1) << 5)); }
__device__ __forceinline__ void stage_rc(int b, int& R, int& C) { const int st = b / 1024, sb = b % 1024, swz = sb ^ (((sb >> 9) & 1) << 5); R = (st >> 1) * 16 + swz / 64; C = (st & 1) * 32 + (swz % 64) / 2; }
__device__ __forceinline__ int perm32(int rho) { const int n = rho >> 4, i = rho & 15; return 8 * (i >> 2) + 4 * n + (i & 3); }

typedef __amdgpu_buffer_rsrc_t rsrc_t;
__device__ __forceinline__ rsrc_t mk_rsrc(const void* p) { return __builtin_amdgcn_make_buffer_rsrc((void*)p, 0, 0x7fffffff, 0x00020000); }
__device__ __forceinline__ void bglds16(rsrc_t r, unsigned voff, unsigned soff, LAS char* l) { __builtin_amdgcn_raw_ptr_buffer_load_lds(r, (LAS unsigned*)l, 16, (int)voff, (int)soff, 0, 0); }

template <class Epi>
__device__ __forceinline__ void gemm_unit(LAS char* lds, const rsrc_t RA, const unsigned (&ao)[2][2], const rsrc_t RB0, const rsrc_t RB1, const unsigned (&bo)[2], const Epi& E,
                                          const int pre = 0, const int nx = 0, const rsrc_t RB0n = rsrc_t(), const rsrc_t RB1n = rsrc_t(), const unsigned (&bon)[2] = {0u, 0u}) {
  const int tid = otid(), wid = __builtin_amdgcn_readfirstlane(tid >> 6), lane = tid & 63, wr = wid >> 2, wc = wid & 3, fr = lane & 15, fq = lane >> 4;
  const unsigned ldsw = (unsigned)wid * 1024u;
  const int aoff = lds_byte(wr * 64 + fr, fq * 8), boff = lds_byte(wc * 32 + fr, fq * 8);
#define G_SA(b, h) (((b) * 2 + (h)) * HTB)
#define G_SB(b, h) ((4 + (b) * 2 + (h)) * HTB)
#define G_STAGE_A(b, h, kt) do { const unsigned _so = (unsigned)(kt) * (BK * 2); bglds16(RA, ao[h][0], _so, lds + G_SA(b, h) + ldsw); bglds16(RA, ao[h][1], _so, lds + G_SA(b, h) + ldsw + 8192); } while (0)
#define G_STAGE_B(b, h, kt) do { const unsigned _so = (unsigned)(kt) * (BK * 2); bglds16((h) ? RB1 : RB0, bo[0], _so, lds + G_SB(b, h) + ldsw); bglds16((h) ? RB1 : RB0, bo[1], _so, lds + G_SB(b, h) + ldsw + 8192); } while (0)
#define G_LDA(dst, b, h) do { _Pragma("unroll") for (int m = 0; m < 4; ++m) _Pragma("unroll") for (int k = 0; k < 2; ++k) dst[m][k] = *(const LAS bf16x8*)(lds + G_SA(b, h) + aoff + m * 2048 + k * 1024); } while (0)
#define G_LDB(dst, b, h) do { _Pragma("unroll") for (int n = 0; n < 2; ++n) _Pragma("unroll") for (int k = 0; k < 2; ++k) dst[n][k] = *(const LAS bf16x8*)(lds + G_SB(b, h) + boff + n * 2048 + k * 1024); } while (0)
#define G_MMA(ai, bj, At, Bt) do { __builtin_amdgcn_s_setprio(1); _Pragma("unroll") for (int m = 0; m < 4; ++m) _Pragma("unroll") for (int n = 0; n < 2; ++n) _Pragma("unroll") for (int k = 0; k < 2; ++k) \
    acc[ai][bj][m][n] = __builtin_amdgcn_mfma_f32_16x16x32_bf16(Bt[n][k], At[m][k], acc[ai][bj][m][n], 0, 0, 0); __builtin_amdgcn_s_setprio(0); } while (0)
#define G_WV(n) asm volatile("s_waitcnt vmcnt(" #n ")" ::: "memory")
#define G_WL(n) asm volatile("s_waitcnt lgkmcnt(" #n ")" ::: "memory")
#define G_BAR __builtin_amdgcn_s_barrier()
#define G_SCHED __builtin_amdgcn_sched_barrier(0)
  f32x4 acc[2][2][4][2];
#pragma unroll
  for (int a = 0; a < 2; ++a)
#pragma unroll
    for (int b = 0; b < 2; ++b)
#pragma unroll
      for (int m = 0; m < 4; ++m)
#pragma unroll
        for (int n = 0; n < 2; ++n) acc[a][b][m][n] = (f32x4){0.f, 0.f, 0.f, 0.f};
  bf16x8 At[4][2], Bq0[2][2], Bq1[2][2];
  if (!pre) { G_STAGE_B(0, 0, 0); G_STAGE_A(0, 0, 0); G_STAGE_B(0, 1, 0); G_STAGE_A(0, 1, 0); }
  if (wr == 1) G_BAR;
  G_WV(4); G_BAR;
  G_STAGE_B(1, 0, 1); G_STAGE_A(1, 0, 1); G_STAGE_B(1, 1, 1);
  G_WV(6); G_BAR;
  for (int t = 0; t < NKT - 2; t += 2) {
    G_LDB(Bq0, 0, 0); G_SCHED; G_LDA(At, 0, 0); G_STAGE_A(1, 1, t + 1);
    G_WL(8); G_BAR; G_WL(0); G_MMA(0, 0, At, Bq0); G_BAR; G_SCHED;
    G_LDB(Bq1, 0, 1); G_STAGE_B(0, 0, t + 2);
    G_BAR; G_WL(0); G_MMA(0, 1, At, Bq1); G_BAR;
    G_LDA(At, 0, 1); G_STAGE_A(0, 0, t + 2);
    G_BAR; G_WL(0); G_MMA(1, 0, At, Bq0); G_BAR; G_SCHED;
    G_STAGE_B(0, 1, t + 2);
    G_WV(6); G_BAR; G_MMA(1, 1, At, Bq1); G_BAR;
    G_LDB(Bq0, 1, 0); G_SCHED; G_LDA(At, 1, 0); G_STAGE_A(0, 1, t + 2);
    G_WL(8); G_BAR; G_WL(0); G_MMA(0, 0, At, Bq0); G_BAR; G_SCHED;
    G_LDB(Bq1, 1, 1); G_STAGE_B(1, 0, t + 3);
    G_BAR; G_WL(0); G_MMA(0, 1, At, Bq1); G_BAR;
    G_LDA(At, 1, 1); G_STAGE_A(1, 0, t + 3);
    G_BAR; G_WL(0); G_MMA(1, 0, At, Bq0); G_BAR; G_SCHED;
    G_STAGE_B(1, 1, t + 3);
    G_WV(6); G_BAR; G_MMA(1, 1, At, Bq1); G_BAR;
  }
  { G_LDB(Bq0, 0, 0); G_LDA(At, 0, 0); G_STAGE_A(1, 1, NKT - 1);
    G_BAR; G_WL(0); G_MMA(0, 0, At, Bq0); G_BAR;
    G_LDB(Bq1, 0, 1); G_BAR; G_WL(0); G_MMA(0, 1, At, Bq1); G_BAR;
    G_LDA(At, 0, 1); G_WV(4); G_BAR; G_WL(0); G_MMA(1, 0, At, Bq0); G_MMA(1, 1, At, Bq1); G_BAR; }
  { G_LDB(Bq0, 1, 0); G_LDA(At, 1, 0); G_WV(2); G_BAR; G_WL(0); G_MMA(0, 0, At, Bq0); G_BAR;
    G_LDB(Bq1, 1, 1); G_WV(0); G_BAR; G_WL(0); G_MMA(0, 1, At, Bq1); G_BAR;
    G_LDA(At, 1, 1); G_BAR; G_WL(0); G_MMA(1, 0, At, Bq0); G_MMA(1, 1, At, Bq1); G_BAR; }
  if (wr == 0) G_BAR;
  if (nx) {
    bglds16(RB0n, bon[0], 0u, lds + G_SB(0, 0) + ldsw); bglds16(RB0n, bon[1], 0u, lds + G_SB(0, 0) + ldsw + 8192); G_STAGE_A(0, 0, 0);
    bglds16(RB1n, bon[0], 0u, lds + G_SB(0, 1) + ldsw); bglds16(RB1n, bon[1], 0u, lds + G_SB(0, 1) + ldsw + 8192); G_STAGE_A(0, 1, 0); }
  { int tz = otid(); asm volatile("" : "+v"(tz)); const int wid2 = tz >> 6, lane2 = tz & 63; E(acc, wid2 >> 2, wid2 & 3, lane2 & 15, lane2 >> 4); }
#undef G_SA
#undef G_SB
#undef G_STAGE_A
#undef G_STAGE_B
#undef G_LDA
#undef G_LDB
#undef G_MMA
#undef G_WV
#undef G_WL
#undef G_BAR
#undef G_SCHED
}


__device__ __forceinline__ u32x4 bl_asm0(unsigned voff, rsrc_t r, unsigned soff) { u32x4 x; asm volatile("s_nop 4\n\tbuffer_load_dwordx4 %0, %1, %2, %3 offen" : "=v"(x) : "v"(voff), "s"(r), "s"(soff) : "memory"); return x; }
__device__ __forceinline__ u32x4 bl_asm1(unsigned voff, rsrc_t r, unsigned soff) { u32x4 x; asm volatile("buffer_load_dwordx4 %0, %1, %2, %3 offen" : "=v"(x) : "v"(voff), "s"(r), "s"(soff) : "memory"); return x; }
template <int OFF> __device__ __forceinline__ s16x4 trb(int vb) { s16x4 r; asm volatile("ds_read_b64_tr_b16 %0, %1 offset:%2" : "=v"(r) : "v"(vb), "i"(OFF) : "memory"); return r; }
template <bool HALF, class Epi>
__device__ __forceinline__ void gemm_unit_f32b(LAS char* lds, const rsrc_t RA, const unsigned (&ao)[2][2], const rsrc_t RB0, const rsrc_t RB1, const Epi& E) {
  const int tid = otid(), wid = __builtin_amdgcn_readfirstlane(tid >> 6), lane = tid & 63, wr = wid >> 2, wc = wid & 3, fr = lane & 15, fq = lane >> 4;
  const unsigned ldsw = (unsigned)wid * 1024u;
  const int aoff = lds_byte(wr * 64 + fr, fq * 8);
  constexpr int BREG = 65536;
  const int ldsb = (int)(unsigned)(uintptr_t)lds;
  const int q4 = fr >> 2, pp = lane & 3, frd = q4 | ((fq & 1) << 2);
  const int kb = ldsb + BREG + (8 * fq + q4) * 512 + pp * 8;
  const int brd0 = kb + (((2 * wc + 0) ^ frd) << 5), brd1 = kb + (((2 * wc + 1) ^ frd) << 5);
  const int n4 = lane & 31, hiw = lane >> 5, fwx = hiw | ((wid & 1) << 2), fwy = fwx ^ 2;
  LAS char* bwx = lds + BREG + (8 * wid + hiw) * 512 + (((n4 >> 2) ^ fwx) << 5) + (n4 & 3) * 8;
  LAS char* bwy = lds + BREG + (8 * wid + hiw + 2) * 512 + (((n4 >> 2) ^ fwy) << 5) + (n4 & 3) * 8;
  const unsigned bvoff = (unsigned)(hiw * 8192 + n4 * 16);
  const unsigned bsw = (unsigned)wid * 65536u;
#define F_SA(b, h) (((b) * 2 + (h)) * HTB)
#define F_STAGE_A(b, h, kt) do { const unsigned _so = (unsigned)(kt) * (BK * 2); bglds16(RA, ao[h][0], _so, lds + F_SA(b, h) + ldsw); bglds16(RA, ao[h][1], _so, lds + F_SA(b, h) + ldsw + 8192); } while (0)
#define F_LDA(dst, b, h) do { _Pragma("unroll") for (int m = 0; m < 4; ++m) _Pragma("unroll") for (int k = 0; k < 2; ++k) dst[m][k] = *(const LAS bf16x8*)(lds + F_SA(b, h) + aoff + m * 2048 + k * 1024); } while (0)
#define F_TR1(dst, base, b, ks, bj) do { const s16x4 _l = trb<(b) * 32768 + (ks) * 16384 + (bj) * 256>(base), _h = trb<(b) * 32768 + (ks) * 16384 + 2048 + (bj) * 256>(base); \
    dst = (bf16x8){_l[0], _l[1], _l[2], _l[3], _h[0], _h[1], _h[2], _h[3]}; } while (0)
#define F_LDB(dst, b, bj) do { F_TR1(dst[0][0], brd0, b, 0, bj); F_TR1(dst[0][1], brd0, b, 1, bj); F_TR1(dst[1][0], brd1, b, 0, bj); F_TR1(dst[1][1], brd1, b, 1, bj); } while (0)
#define F_MMA(ai, bj, At, Bt) do { __builtin_amdgcn_s_setprio(1); _Pragma("unroll") for (int m = 0; m < 4; ++m) _Pragma("unroll") for (int n = 0; n < 2; ++n) _Pragma("unroll") for (int k = 0; k < 2; ++k) \
    acc[ai][bj][m][n] = __builtin_amdgcn_mfma_f32_16x16x32_bf16(Bt[n][k], At[m][k], acc[ai][bj][m][n], 0, 0, 0); __builtin_amdgcn_s_setprio(0); } while (0)
#define F_BLOAD(SX, SY, kt, i) do { const unsigned _so = (unsigned)(kt) * 524288u + bsw + (unsigned)((i) >> 1) * 32768u; \
    const unsigned _so2 = _so + 16384u; if ((i) & 1) { SX = bl_asm1(bvoff, RB1, _so); SY = bl_asm1(bvoff, RB1, _so2); } else { SX = bl_asm1(bvoff, RB0, _so); SY = bl_asm1(bvoff, RB0, _so2); } } while (0)
#define F_BLOAD_FIRST(SX, SY) do { SX = bl_asm0(bvoff, RB0, bsw); SY = bl_asm1(bvoff, RB0, bsw + 16384u); } while (0)
#define F_BWAIT(SX, SY, n) asm volatile("s_waitcnt vmcnt(" #n ")" : "+v"(SX), "+v"(SY) :: "memory")
#define F_BWRITE(SX, SY, b, i) do { u32x2 _wx, _wy; _wx.x = cvt_pk_bf16(__uint_as_float(SX.x), __uint_as_float(SX.y)); _wx.y = cvt_pk_bf16(__uint_as_float(SX.z), __uint_as_float(SX.w)); \
    _wy.x = cvt_pk_bf16(__uint_as_float(SY.x), __uint_as_float(SY.y)); _wy.y = cvt_pk_bf16(__uint_as_float(SY.z), __uint_as_float(SY.w)); \
    *(LAS u32x2*)(bwx + (b) * 32768 + ((i) >> 1) * 2048 + ((i) & 1) * 256) = _wx; *(LAS u32x2*)(bwy + (b) * 32768 + ((i) >> 1) * 2048 + ((i) & 1) * 256) = _wy; } while (0)
#define F_BWAITH(SX, SY, nfull, nhalf) do { if constexpr (HALF) { F_BWAIT(SX, SY, nhalf); } else { F_BWAIT(SX, SY, nfull); } } while (0)
#define F_WL(n) asm volatile("s_waitcnt lgkmcnt(" #n ")" ::: "memory")
#define F_BAR __builtin_amdgcn_s_barrier()
#define F_SCHED __builtin_amdgcn_sched_barrier(0)
  f32x4 acc[2][2][4][2];
  E.init(acc, wc, fq);
  bf16x8 At[4][2], Bq0[2][2], Bq1[2][2];
  u32x4 Ex, Ey, Ox, Oy;
  F_STAGE_A(0, 0, 0); if constexpr (!HALF) F_STAGE_A(0, 1, 0); F_STAGE_A(1, 0, 1);
  { u32x4 P0x, P0y, P1x, P1y, P2x, P2y, P3x, P3y, P4x, P4y;
    F_BLOAD_FIRST(P0x, P0y); F_BLOAD(P1x, P1y, 0, 1); F_BLOAD(P2x, P2y, 0, 2); F_BLOAD(P3x, P3y, 0, 3); F_BLOAD(P4x, P4y, 1, 0);
    F_BLOAD(Ox, Oy, 1, 1); F_BLOAD(Ex, Ey, 1, 2);
    F_BWAIT(P0x, P0y, 12); F_BWRITE(P0x, P0y, 0, 0);
    F_BWAIT(P1x, P1y, 10); F_BWRITE(P1x, P1y, 0, 1);
    F_BWAIT(P2x, P2y, 8); F_BWRITE(P2x, P2y, 0, 2);
    F_BWAIT(P3x, P3y, 6); F_BWRITE(P3x, P3y, 0, 3);
    F_BWAIT(P4x, P4y, 4); F_BWRITE(P4x, P4y, 1, 0); }
  F_WL(0);
  if (wr == 1) F_BAR;
  F_BAR;
  for (int t = 0; t < NKT - 2; t += 2) {
    const int t2 = t + 2, t3 = t + 3;
    F_LDB(Bq0, 0, 0); F_LDA(At, 0, 0); if constexpr (!HALF) F_STAGE_A(1, 1, t + 1);
    F_BWAITH(Ox, Oy, 4, 2); F_BWRITE(Ox, Oy, 1, 1); F_BLOAD(Ox, Oy, t + 1, 3);
    F_BAR; F_WL(0); F_SCHED; F_MMA(0, 0, At, Bq0); F_BAR; F_SCHED;
    F_LDB(Bq1, 0, 1);
    F_BWAITH(Ex, Ey, 4, 2); F_BWRITE(Ex, Ey, 1, 2); F_BLOAD(Ex, Ey, t2, 0);
    F_BAR; F_WL(0); F_SCHED; F_MMA(0, 1, At, Bq1); F_BAR; F_SCHED;
    if constexpr (!HALF) F_LDA(At, 0, 1); F_STAGE_A(0, 0, t2);
    F_BWAIT(Ox, Oy, 4); F_BWRITE(Ox, Oy, 1, 3); F_BLOAD(Ox, Oy, t2, 1);
    F_BAR; F_WL(0); F_SCHED; if constexpr (!HALF) F_MMA(1, 0, At, Bq0); F_BAR; F_SCHED;
    F_BWAIT(Ex, Ey, 4); F_BWRITE(Ex, Ey, 0, 0); F_BLOAD(Ex, Ey, t2, 2);
    F_BAR; F_WL(0); F_SCHED; if constexpr (!HALF) F_MMA(1, 1, At, Bq1); F_BAR; F_SCHED;
    F_LDB(Bq0, 1, 0); F_LDA(At, 1, 0); if constexpr (!HALF) F_STAGE_A(0, 1, t2);
    F_BWAITH(Ox, Oy, 4, 2); F_BWRITE(Ox, Oy, 0, 1); F_BLOAD(Ox, Oy, t2, 3);
    F_BAR; F_WL(0); F_SCHED; F_MMA(0, 0, At, Bq0); F_BAR; F_SCHED;
    F_LDB(Bq1, 1, 1);
    F_BWAITH(Ex, Ey, 4, 2); F_BWRITE(Ex, Ey, 0, 2); F_BLOAD(Ex, Ey, t3, 0);
    F_BAR; F_WL(0); F_SCHED; F_MMA(0, 1, At, Bq1); F_BAR; F_SCHED;
    if constexpr (!HALF) F_LDA(At, 1, 1); F_STAGE_A(1, 0, t3);
    F_BWAIT(Ox, Oy, 4); F_BWRITE(Ox, Oy, 0, 3); F_BLOAD(Ox, Oy, t3, 1);
    F_BAR; F_WL(0); F_SCHED; if constexpr (!HALF) F_MMA(1, 0, At, Bq0); F_BAR; F_SCHED;
    F_BWAIT(Ex, Ey, 4); F_BWRITE(Ex, Ey, 1, 0); F_BLOAD(Ex, Ey, t3, 2);
    F_BAR; F_WL(0); F_SCHED; if constexpr (!HALF) F_MMA(1, 1, At, Bq1); F_BAR; F_SCHED;
  }
  {
    F_LDB(Bq0, 0, 0); F_LDA(At, 0, 0); if constexpr (!HALF) F_STAGE_A(1, 1, NKT - 1);
    F_BWAITH(Ox, Oy, 4, 2); F_BWRITE(Ox, Oy, 1, 1); F_BLOAD(Ox, Oy, NKT - 1, 3);
    F_BAR; F_WL(0); F_SCHED; F_MMA(0, 0, At, Bq0); F_BAR; F_SCHED;
    F_LDB(Bq1, 0, 1);
    F_BWAITH(Ex, Ey, 4, 2); F_BWRITE(Ex, Ey, 1, 2);
    F_BAR; F_WL(0); F_SCHED; F_MMA(0, 1, At, Bq1); F_BAR; F_SCHED;
    if constexpr (!HALF) F_LDA(At, 0, 1);
    F_BWAIT(Ox, Oy, 0); F_BWRITE(Ox, Oy, 1, 3);
    F_BAR; F_WL(0); F_SCHED; if constexpr (!HALF) F_MMA(1, 0, At, Bq0); F_BAR; F_SCHED;
    F_BAR; F_SCHED; if constexpr (!HALF) F_MMA(1, 1, At, Bq1); F_BAR; F_SCHED;
    F_LDB(Bq0, 1, 0); F_LDA(At, 1, 0);
    F_BAR; F_WL(0); F_SCHED; F_MMA(0, 0, At, Bq0); F_BAR; F_SCHED;
    F_LDB(Bq1, 1, 1);
    F_BAR; F_WL(0); F_SCHED; F_MMA(0, 1, At, Bq1); F_BAR; F_SCHED;
    if constexpr (!HALF) F_LDA(At, 1, 1);
    E.template part<0, 0, 2>(acc, wr, wc, fr, fq);
    F_BAR; F_WL(0); F_SCHED; if constexpr (!HALF) F_MMA(1, 0, At, Bq0); F_BAR; F_SCHED;
    E.template part<0, 2, 4>(acc, wr, wc, fr, fq);
    F_BAR; F_SCHED; if constexpr (!HALF) F_MMA(1, 1, At, Bq1); F_BAR; F_SCHED;
  }
  if (wr == 0) F_BAR;
  if constexpr (!HALF) { int tz = threadIdx.x; asm volatile("" : "+v"(tz)); const int wid2 = tz >> 6, lane2 = tz & 63; E.template part<1, 0, 4>(acc, wid2 >> 2, wid2 & 3, lane2 & 15, lane2 >> 4); }
#undef F_SA
#undef F_STAGE_A
#undef F_LDA
#undef F_TR1
#undef F_LDB
#undef F_MMA
#undef F_BLOAD
#undef F_BLOAD_FIRST
#undef F_BWAIT
#undef F_BWAITH
#undef F_BWRITE
#undef F_WL
#undef F_BAR
#undef F_SCHED
}

template <bool PERM> __device__ __forceinline__ void b_offsets(unsigned (&bo)[2]) {
#pragma unroll
  for (int i = 0; i < 2; ++i) { int R, C; stage_rc(otid() * 16 + i * 8192, R, C); const int Rb = PERM ? ((R & ~31) + perm32(R & 31)) : R; bo[i] = (unsigned)(Rb * KDIM + C) * 2u; }
}

__device__ __forceinline__ void ph_norm_gd(const Params& p, LAS char* lds) {
  const int tid = otid(), wid = tid >> 6, lane = tid & 63;
  f32x4 nw[8];
#pragma unroll
  for (int i = 0; i < 8; ++i) nw[i] = *(const f32x4*)(p.attn_norm_w + (i >> 1) * 512 + lane * 8 + (i & 1) * 4);
  for (int row = (blockIdx.x * 8 + wid) * 2; row < T_TOK; row += gridDim.x * 16) {
    const float* xr = p.x + (size_t)row * DM;
    f32x4 v[8], w2[8]; float ss = 0.f, s2 = 0.f;
#pragma unroll
    for (int i = 0; i < 8; ++i) { const int co = (i >> 1) * 512 + lane * 8 + (i & 1) * 4; v[i] = *(const f32x4*)(xr + co); w2[i] = *(const f32x4*)(xr + DM + co); }
#pragma unroll
    for (int i = 0; i < 8; ++i) { ss += v[i][0] * v[i][0] + v[i][1] * v[i][1] + v[i][2] * v[i][2] + v[i][3] * v[i][3]; s2 += w2[i][0] * w2[i][0] + w2[i][1] * w2[i][1] + w2[i][2] * w2[i][2] + w2[i][3] * w2[i][3]; }
    ss = wave_sum(ss); s2 = wave_sum(s2);
    const float rstd = rsqrtf(ss * (1.0f / 2048.0f) + 1e-6f), rstd2 = rsqrtf(s2 * (1.0f / 2048.0f) + 1e-6f);
#pragma unroll
    for (int i = 0; i < 4; ++i) { const f32x4 a0 = v[2 * i] * rstd * nw[2 * i], a1 = v[2 * i + 1] * rstd * nw[2 * i + 1], b0 = w2[2 * i] * rstd2 * nw[2 * i], b1 = w2[2 * i + 1] * rstd2 * nw[2 * i + 1];
      u32x4 o; o.x = cvt_pk_bf16(a0[0], a0[1]); o.y = cvt_pk_bf16(a0[2], a0[3]); o.z = cvt_pk_bf16(a1[0], a1[1]); o.w = cvt_pk_bf16(a1[2], a1[3]); *(u32x4*)(p.hn + (size_t)row * DM + i * 512 + lane * 8) = o;
      u32x4 o2; o2.x = cvt_pk_bf16(b0[0], b0[1]); o2.y = cvt_pk_bf16(b0[2], b0[3]); o2.z = cvt_pk_bf16(b1[0], b1[1]); o2.w = cvt_pk_bf16(b1[2], b1[3]); *(u32x4*)(p.hn + (size_t)(row + 1) * DM + i * 512 + lane * 8) = o2; }
  }
}
__device__ __forceinline__ void ph_gdown(const Params& p, LAS char* lds) {
  const int tid = otid(), wid = tid >> 6, lane = tid & 63, fr = lane & 15, fq = lane >> 4, rt = wid >> 2, kq = wid & 3;
  LAS float* part = (LAS float*)lds;
  for (int task = blockIdx.x; task < T_TOK / 32; task += gridDim.x) {
    const int row = task * 32 + rt * 16 + fr;
    const bf16_t* ar = p.hn + (size_t)row * DM + kq * 512 + fq * 8;
    const bf16_t* wh = p.wgd_hi + fr * 2048 + kq * 512 + fq * 8; const bf16_t* wl = p.wgd_lo + fr * 2048 + kq * 512 + fq * 8;
    f32x4 acc = {0.f, 0.f, 0.f, 0.f};
#pragma unroll 8
    for (int ks = 0; ks < 16; ++ks) { const bf16x8 a = *(const bf16x8*)(ar + ks * 32), bh = *(const bf16x8*)(wh + ks * 32), bl = *(const bf16x8*)(wl + ks * 32);
      acc = __builtin_amdgcn_mfma_f32_16x16x32_bf16(a, bh, acc, 0, 0, 0); acc = __builtin_amdgcn_mfma_f32_16x16x32_bf16(a, bl, acc, 0, 0, 0); }
    LAS float* pw_ = part + (rt * 4 + kq) * (16 * 17);
#pragma unroll
    for (int r = 0; r < 4; ++r) pw_[(fq * 4 + r) * 17 + fr] = acc[r];
    __syncthreads();
    if (tid < 512) { const int rr = tid >> 4, cc = tid & 15, rt2 = rr >> 4, r16 = rr & 15; const LAS float* q_ = part + (rt2 * 4) * (16 * 17) + r16 * 17 + cc;
      p.gd[(size_t)(task * 32 + rr) * 16 + cc] = q_[0] + q_[16 * 17] + q_[2 * 16 * 17] + q_[3 * 16 * 17]; }
    __syncthreads();
  }
}

__device__ __forceinline__ void ph_convert(const Params& p, LAS char* lds) {
  const int tid = otid();
  LAS float* tile = (LAS float*)lds;
  constexpr int NT_TOTAL = 1536 + 512;
  auto tile_src = [&](int tI, const float*& src, bf16_t*& dst, int& ld, int& k0, int& n0) { int ntn, local;
    if (tI < 1536) { src = p.w_in; dst = p.wt_in; ld = LDW; ntn = 48; local = tI; } else { src = p.w_out; dst = p.wt_out; ld = 2048; ntn = 16; local = tI - 1536; }
    const int tn = local % ntn, tk = local / ntn; k0 = tk * 64; n0 = tn * 128; };
  const int lr = tid >> 5, lc4 = (tid & 31) * 4;
  f32x4 pv[4];
  { const int tI = blockIdx.x; if (tI < NT_TOTAL) { const float* src; bf16_t* dst; int ld, k0, n0; tile_src(tI, src, dst, ld, k0, n0);
#pragma unroll
      for (int ps = 0; ps < 4; ++ps) pv[ps] = *(const f32x4*)(src + (size_t)(k0 + ps * 16 + lr) * ld + n0 + lc4); } }
  for (int tI = blockIdx.x; tI < NT_TOTAL; tI += gridDim.x) {
    const float* src; bf16_t* dst; int ld, k0, n0; tile_src(tI, src, dst, ld, k0, n0);
#pragma unroll
    for (int ps = 0; ps < 4; ++ps) *(LAS f32x4*)(tile + (ps * 16 + lr) * 132 + lc4) = pv[ps];
    __syncthreads();
    { const int tN = tI + gridDim.x; if (tN < NT_TOTAL) { const float* s2; bf16_t* d2; int ld2, k2, n2; tile_src(tN, s2, d2, ld2, k2, n2);
#pragma unroll
        for (int ps = 0; ps < 4; ++ps) pv[ps] = *(const f32x4*)(s2 + (size_t)(k2 + ps * 16 + lr) * ld2 + n2 + lc4); } }
    { const int n = tid >> 2, kq = (tid & 3) * 16; float f[16];
#pragma unroll
      for (int j = 0; j < 16; ++j) f[j] = tile[(kq + j) * 132 + n];
      u32x4 a, b; a.x = cvt_pk_bf16(f[0], f[1]); a.y = cvt_pk_bf16(f[2], f[3]); a.z = cvt_pk_bf16(f[4], f[5]); a.w = cvt_pk_bf16(f[6], f[7]);
      b.x = cvt_pk_bf16(f[8], f[9]); b.y = cvt_pk_bf16(f[10], f[11]); b.z = cvt_pk_bf16(f[12], f[13]); b.w = cvt_pk_bf16(f[14], f[15]);
      bf16_t* o = dst + (size_t)(n0 + n) * 2048 + k0 + kq; *(u32x4*)o = a; *(u32x4*)(o + 8) = b; }
    __syncthreads();
  }
  for (int i = blockIdx.x * 512 + tid; i < 2048 * 32; i += gridDim.x * 512) { const int d = i >> 5, e = i & 31; const float w = p.router_w[i];
    const bf16_t h = f2bf(w); const bf16_t l = f2bf(w - bf2f(h)); p.wr_hi[e * 2048 + d] = h; p.wr_lo[e * 2048 + d] = l; }
  for (int i = blockIdx.x * 512 + tid; i < 2048 * 16; i += gridDim.x * 512) { const int d = i >> 4, c = i & 15; const float w = p.w_in[(size_t)d * LDW + 6144 + c];
    const bf16_t h = f2bf(w); const bf16_t l = f2bf(w - bf2f(h)); p.wgd_hi[c * 2048 + d] = h; p.wgd_lo[c * 2048 + d] = l; }
}

struct EpiProj { bf16_t* O; int pm, pn, ld;
  __device__ __forceinline__ void operator()(const f32x4 (&acc)[2][2][4][2], int wr, int wc, int fr, int fq) const {
#pragma unroll
    for (int ai = 0; ai < 2; ++ai)
#pragma unroll
      for (int m = 0; m < 4; ++m) { bf16_t* rowp = O + (size_t)(pm * 256 + ai * 128 + wr * 64 + m * 16 + fr) * ld + pn * 256 + wc * 32 + 8 * fq;
#pragma unroll
        for (int bj = 0; bj < 2; ++bj) { const f32x4 v0 = acc[ai][bj][m][0], v1 = acc[ai][bj][m][1]; u32x4 w; w.x = cvt_pk_bf16(v0[0], v0[1]); w.y = cvt_pk_bf16(v0[2], v0[3]); w.z = cvt_pk_bf16(v1[0], v1[1]); w.w = cvt_pk_bf16(v1[2], v1[3]);
          *(u32x4*)(rowp + bj * 128) = w; } }
  } };
struct EpiProjK { bf16_t* O; const float* kw; int pm, pn;
  __device__ __forceinline__ void operator()(const f32x4 (&acc)[2][2][4][2], int wr, int wc, int fr, int fq) const {
    f32x4 w4[2][2];
#pragma unroll
    for (int bj = 0; bj < 2; ++bj) { w4[bj][0] = *(const f32x4*)(kw + bj * 32 + 8 * fq); w4[bj][1] = *(const f32x4*)(kw + bj * 32 + 8 * fq + 4); }
#pragma unroll
    for (int ai = 0; ai < 2; ++ai)
#pragma unroll
      for (int m = 0; m < 4; ++m) { bf16_t* rowp = O + (size_t)(pm * 256 + ai * 128 + wr * 64 + m * 16 + fr) * NP + pn * 256 + wc * 64 + 8 * fq;
        float ss = 0.f;
#pragma unroll
        for (int bj = 0; bj < 2; ++bj)
#pragma unroll
          for (int n = 0; n < 2; ++n) { const f32x4 v = acc[ai][bj][m][n]; ss += v[0] * v[0] + v[1] * v[1] + v[2] * v[2] + v[3] * v[3]; }
        ss += __shfl_xor(ss, 16); ss += __shfl_xor(ss, 32);
        const float rstd = rsqrtf(ss * (1.0f / 64.0f) + 1e-6f);
#pragma unroll
        for (int bj = 0; bj < 2; ++bj) { const f32x4 v0 = acc[ai][bj][m][0] * rstd * w4[bj][0], v1 = acc[ai][bj][m][1] * rstd * w4[bj][1];
          u32x4 w; w.x = cvt_pk_bf16(v0[0], v0[1]); w.y = cvt_pk_bf16(v0[2], v0[3]); w.z = cvt_pk_bf16(v1[0], v1[1]); w.w = cvt_pk_bf16(v1[2], v1[3]);
          *(u32x4*)(rowp + bj * 32) = w; } }
  } };
__device__ __forceinline__ void ph_inproj(const Params& p, LAS char* lds) {
  unsigned bo[2]; b_offsets<true>(bo);
  unsigned boK[2];
#pragma unroll
  for (int i = 0; i < 2; ++i) { int R, C; stage_rc(otid() * 16 + i * 8192, R, C); boK[i] = (unsigned)(((R >> 5) * 64 + perm32(R & 31)) * KDIM + C) * 2u; }
  int pre = 0;
  for (int u = blockIdx.x; u < 32 * 24; u += gridDim.x) {
    const int pm = u & 31, pn = u >> 5;
    unsigned ao[2][2];
#pragma unroll
    for (int h = 0; h < 2; ++h)
#pragma unroll
      for (int i = 0; i < 2; ++i) { int R, C; stage_rc(otid() * 16 + i * 8192, R, C); ao[h][i] = (unsigned)((pm * 256 + h * 128 + R) * KDIM + C) * 2u; }
    const int un = u + gridDim.x, pnn = un >> 5, nx = (un < 32 * 24 && (un & 31) == pm) ? 1 : 0, kn = (pnn >= 4 && pnn < 8) ? 1 : 0;
    const rsrc_t RB0n = mk_rsrc(p.wt_in + (size_t)(pnn * 256) * KDIM), RB1n = mk_rsrc(p.wt_in + (size_t)(pnn * 256 + (kn ? 32 : 128)) * KDIM);
    unsigned bon[2]; bon[0] = kn ? boK[0] : bo[0]; bon[1] = kn ? boK[1] : bo[1];
    if (pn >= 4 && pn < 8) { EpiProjK E{p.proj, p.k_norm_w, pm, pn};
      gemm_unit(lds, mk_rsrc(p.hn), ao, mk_rsrc(p.wt_in + (size_t)(pn * 256) * KDIM), mk_rsrc(p.wt_in + (size_t)(pn * 256 + 32) * KDIM), boK, E, pre, nx, RB0n, RB1n, bon); }
    else { EpiProj E{p.proj, pm, pn, NP};
      gemm_unit(lds, mk_rsrc(p.hn), ao, mk_rsrc(p.wt_in + (size_t)(pn * 256) * KDIM), mk_rsrc(p.wt_in + (size_t)(pn * 256 + 128) * KDIM), bo, E, pre, nx, RB0n, RB1n, bon); }
    pre = nx;
    __syncthreads();
  }
}

template <int KSTEPS> __device__ __forceinline__ f32x4 mma_tile(const LAS bf16_t* A, int lda, const LAS bf16_t* B, int ldb, int fr, int fq) {
  f32x4 c = {0.f, 0.f, 0.f, 0.f};
#pragma unroll
  for (int ks = 0; ks < KSTEPS; ++ks) { const bf16x8 a = *(const LAS bf16x8*)(A + fr * lda + ks * 32 + fq * 8); const bf16x8 b = *(const LAS bf16x8*)(B + fr * ldb + ks * 32 + fq * 8);
    c = __builtin_amdgcn_mfma_f32_16x16x32_bf16(a, b, c, 0, 0, 0); }
  return c;
}

constexpr int G_LQ = 136, G_LK = 72;
constexpr int G1_GD = 0, G1_PART = 4096, G1_QS = 6144, G1_KS = G1_QS + 64 * G_LQ * 2, G1_KHT = G1_KS + 64 * G_LQ * 2, G1_VI = G1_KHT + 128 * G_LK * 2, G1_AS = G1_VI + 64 * 512;
template <int OFF> __device__ __forceinline__ s16x4 trv(int vb) { s16x4 r; asm volatile("ds_read_b64_tr_b16 %0, %1 offset:%2" : "=v"(r) : "v"(vb), "i"(OFF) : "memory"); return r; }
__device__ __forceinline__ void ph_gla1(const Params& p, LAS char* lds) {
  const int tid = otid(), wid = tid >> 6, lane = tid & 63, fr = lane & 15, fq = lane >> 4;
  LAS float* gdS = (LAS float*)(lds + G1_GD); LAS float* partS = (LAS float*)(lds + G1_PART);
  LAS bf16_t* Qs = (LAS bf16_t*)(lds + G1_QS); LAS bf16_t* Ks = (LAS bf16_t*)(lds + G1_KS); LAS bf16_t* Kht = (LAS bf16_t*)(lds + G1_KHT);
  LAS char* VI = lds + G1_VI; LAS bf16_t* As = (LAS bf16_t*)(lds + G1_AS);
  const int q4 = fr >> 2, pp = lane & 3, fv = q4 | ((fq & 1) << 2);
  const int vlane = (int)(unsigned)(uintptr_t)VI + (8 * fq + q4) * 512 + pp * 8;
  int hprev = -1; float Wg[16] = {0.f, 0.f, 0.f, 0.f, 0.f, 0.f, 0.f, 0.f, 0.f, 0.f, 0.f, 0.f, 0.f, 0.f, 0.f, 0.f}; float bias = 0.f;
  u32x4 vv[4], qq[2], kk[2]; f32x4 gg = {0.f, 0.f, 0.f, 0.f};
  auto stage_load = [&](int uu) { const int b2 = uu >> 7, h2 = (uu >> 5) & 3, c2 = uu & 31; const size_t tt = (size_t)b2 * SEQ + c2 * 64;
    if (tid < 256) gg = *(const f32x4*)(p.gd + tt * 16 + tid * 4);
#pragma unroll
    for (int i = 0; i < 4; ++i) { const int pc = tid + i * 512, j = pc >> 5, e8 = (pc & 31) * 8; vv[i] = *(const u32x4*)(p.proj + (tt + j) * NP + 4096 + h2 * 256 + e8); }
#pragma unroll
    for (int i = 0; i < 2; ++i) { const int pc = tid + i * 512, row = pc >> 4, c8 = (pc & 15) * 8; const bf16_t* src = p.proj + (tt + row) * NP + 3072 + h2 * 128 + c8;
      qq[i] = *(const u32x4*)src; kk[i] = *(const u32x4*)(src + 512); } };
  if ((int)blockIdx.x < 512) stage_load(blockIdx.x);
  for (int u = blockIdx.x; u < 512; u += gridDim.x) {
    const int b = u >> 7, h = (u >> 5) & 3, c = u & 31; const size_t t0 = (size_t)b * SEQ + c * 64;
    const int d = tid & 127, qt = tid >> 7;
    if (h != hprev) { hprev = h;
#pragma unroll
      for (int r = 0; r < 16; ++r) Wg[r] = p.gate_up_w[r * 512 + h * 128 + d];
      bias = p.gate_up_b[h * 128 + d]; }
    { if (tid < 256) *(LAS f32x4*)(gdS + tid * 4) = gg;
#pragma unroll
      for (int i = 0; i < 4; ++i) { const int pc = tid + i * 512, j = pc >> 5, e8 = (pc & 31) * 8, fj = (j & 3) | (((j >> 3) & 1) << 2);
        *(LAS u32x4*)(VI + j * 512 + (((e8 >> 4) ^ fj) << 5) + (e8 & 15) * 2) = vv[i]; }
#pragma unroll
      for (int i = 0; i < 2; ++i) { const int pc = tid + i * 512, row = pc >> 4, c8 = (pc & 15) * 8; *(LAS u32x4*)(Qs + row * G_LQ + c8) = qq[i]; *(LAS u32x4*)(Ks + row * G_LQ + c8) = kk[i]; } }
    __syncthreads();
    if (u + (int)gridDim.x < 512) stage_load(u + gridDim.x);
    float bc[16]; float run = 0.f;
#pragma unroll
    for (int ii = 0; ii < 16; ++ii) { const int i = qt * 16 + ii; float xg = bias;
#pragma unroll
      for (int r4 = 0; r4 < 4; ++r4) { const f32x4 g4 = *(const LAS f32x4*)(gdS + i * 16 + r4 * 4); xg += g4[0] * Wg[r4 * 4] + g4[1] * Wg[r4 * 4 + 1] + g4[2] * Wg[r4 * 4 + 2] + g4[3] * Wg[r4 * 4 + 3]; }
      const float ls = fminf(xg, 0.f) - __logf(1.0f + __expf(-fabsf(xg)));
      run += ls * (1.0f / 16.0f); bc[ii] = run; }
    partS[qt * 128 + d] = run;
    __syncthreads();
    float pre = 0.f, tot = 0.f;
#pragma unroll
    for (int q = 0; q < 4; ++q) { const float v = partS[q * 128 + d]; tot += v; pre += (q < qt) ? v : 0.f; }
    const float etot = __expf(tot);
    if (qt == 0) p.decay[u * 128 + d] = etot;
    { unsigned kh[8];
#pragma unroll
      for (int ii = 0; ii < 16; ++ii) { const int i = qt * 16 + ii; const float bb = bc[ii] + pre; const float qv = bf2f(Qs[i * G_LQ + d]), kv = bf2f(Ks[i * G_LQ + d]);
        const float eb = __expf(bb), ib = __builtin_amdgcn_rcpf(eb);
        Qs[i * G_LQ + d] = f2bf(qv * 0.08838834764831845f * eb);
        Ks[i * G_LQ + d] = f2bf(kv * ib);
        const unsigned khv = f2bf(kv * (etot * ib)); if (ii & 1) kh[ii >> 1] |= khv << 16; else kh[ii >> 1] = khv; }
      *(LAS u32x4*)(Kht + d * G_LK + qt * 16) = (u32x4){kh[0], kh[1], kh[2], kh[3]}; *(LAS u32x4*)(Kht + d * G_LK + qt * 16 + 8) = (u32x4){kh[4], kh[5], kh[6], kh[7]}; }
    __syncthreads();
#pragma unroll
    for (int i = 0; i < 2; ++i) { const int pc = tid + i * 512, row = pc >> 4, c8 = (pc & 15) * 8; *(u32x4*)(p.qtil + ((size_t)u * 64 + row) * 128 + c8) = *(const LAS u32x4*)(Qs + row * G_LQ + c8); }
    { const int mt = wid >> 1;
#pragma unroll
      for (int q = 0; q < 2; ++q) { const int nt = (wid & 1) * 2 + q; const f32x4 cc = mma_tile<4>(Qs + mt * 16 * G_LQ, G_LQ, Ks + nt * 16 * G_LQ, G_LQ, fr, fq);
#pragma unroll
        for (int r = 0; r < 4; ++r) { const int i = mt * 16 + fq * 4 + r, j = nt * 16 + fr; As[i * G_LK + j] = f2bf(j <= i ? cc[r] : 0.f); } } }
    __syncthreads();
    { bf16_t* oi = p.oib + (size_t)u * 64 * 256; bf16_t* Uo = p.Ub + (size_t)u * 256 * 128; const int odd = fq & 1, c16 = (odd ? 16 : 0) + 8 * (fq >> 1);
      f32x4 oc[2][4];
#pragma unroll
      for (int q = 0; q < 2; ++q) { const int tq = wid * 2 + q;
        const int va = vlane + ((tq ^ fv) << 5);
        const s16x4 l0 = trv<0>(va), h0 = trv<2048>(va), l1 = trv<16384>(va), h1 = trv<16384 + 2048>(va);
        asm volatile("s_waitcnt lgkmcnt(0)" ::: "memory"); __builtin_amdgcn_sched_barrier(0);
        const bf16x8 vf0 = (bf16x8){l0[0], l0[1], l0[2], l0[3], h0[0], h0[1], h0[2], h0[3]}, vf1 = (bf16x8){l1[0], l1[1], l1[2], l1[3], h1[0], h1[1], h1[2], h1[3]};
#pragma unroll
        for (int mt = 0; mt < 4; ++mt) {
          const bf16x8 a0 = *(const LAS bf16x8*)(As + (mt * 16 + fr) * G_LK + fq * 8), a1 = *(const LAS bf16x8*)(As + (mt * 16 + fr) * G_LK + 32 + fq * 8);
          f32x4 cc = {0.f, 0.f, 0.f, 0.f}; cc = __builtin_amdgcn_mfma_f32_16x16x32_bf16(vf0, a0, cc, 0, 0, 0); cc = __builtin_amdgcn_mfma_f32_16x16x32_bf16(vf1, a1, cc, 0, 0, 0);
          oc[q][mt] = cc; }
#pragma unroll
        for (int np = 0; np < 4; ++np) {
          u32x2 wq[2];
#pragma unroll
          for (int z = 0; z < 2; ++z) { const int nt = np * 2 + z;
            const bf16x8 a0 = *(const LAS bf16x8*)(Kht + (nt * 16 + fr) * G_LK + fq * 8), a1 = *(const LAS bf16x8*)(Kht + (nt * 16 + fr) * G_LK + 32 + fq * 8);
            f32x4 cc = {0.f, 0.f, 0.f, 0.f}; cc = __builtin_amdgcn_mfma_f32_16x16x32_bf16(a0, vf0, cc, 0, 0, 0); cc = __builtin_amdgcn_mfma_f32_16x16x32_bf16(a1, vf1, cc, 0, 0, 0);
            wq[z].x = pkc(cc[0], cc[1]); wq[z].y = pkc(cc[2], cc[3]); }
          u32x4 w; quad_pair16(wq[0], wq[1], odd, w);
          *(u32x4*)(Uo + (tq * 16 + fr) * 128 + np * 32 + c16) = w; } }
#pragma unroll
      for (int mt = 0; mt < 4; ++mt) { u32x2 w0, w1; w0.x = pkc(oc[0][mt][0], oc[0][mt][1]); w0.y = pkc(oc[0][mt][2], oc[0][mt][3]); w1.x = pkc(oc[1][mt][0], oc[1][mt][1]); w1.y = pkc(oc[1][mt][2], oc[1][mt][3]);
        u32x4 w; quad_pair16(w0, w1, odd, w);
        *(u32x4*)(oi + (mt * 16 + fr) * 256 + wid * 32 + c16) = w; } }
    __syncthreads();
  }
}

__device__ __forceinline__ void ph_gla_scan(const Params& p, LAS char* lds) {
  const int tid = otid(); LAS float* decS = (LAS float*)lds;
  for (int w = blockIdx.x; w < 256; w += gridDim.x) {
    const int bh = w >> 4, e = (w & 15) * 16 + ((tid & 255) >> 4), d8 = (tid & 15) * 8;
#pragma unroll
    for (int i = 0; i < 2; ++i) *(LAS f32x4*)(decS + (tid + i * 512) * 4) = *(const f32x4*)(p.decay + (size_t)bh * 4096 + (tid + i * 512) * 4);
    __syncthreads();
    if (tid < 256) {
      f32x4 S0 = {0.f, 0.f, 0.f, 0.f}, S1 = {0.f, 0.f, 0.f, 0.f};
#pragma unroll
      for (int hb = 0; hb < 2; ++hb) { u32x4 uv[16];
#pragma unroll
        for (int c = 0; c < 16; ++c) uv[c] = *(const u32x4*)(p.Ub + ((size_t)(bh * 32 + hb * 16 + c) * 256 + e) * 128 + d8);
#pragma unroll
        for (int c = 0; c < 16; ++c) { const int cc = hb * 16 + c; const size_t off = ((size_t)(bh * 32 + cc) * 256 + e) * 128 + d8;
          u32x4 o; o.x = cvt_pk_bf16(S0[0], S0[1]); o.y = cvt_pk_bf16(S0[2], S0[3]); o.z = cvt_pk_bf16(S1[0], S1[1]); o.w = cvt_pk_bf16(S1[2], S1[3]); *(u32x4*)(p.st + off) = o;
          const u32x4 uu = uv[c]; const f32x4 dc0 = *(const LAS f32x4*)(decS + cc * 128 + d8), dc1 = *(const LAS f32x4*)(decS + cc * 128 + d8 + 4);
          const f32x4 u0 = {bflo(uu.x), bfhi(uu.x), bflo(uu.y), bfhi(uu.y)}, u1 = {bflo(uu.z), bfhi(uu.z), bflo(uu.w), bfhi(uu.w)};
          S0 = dc0 * S0 + u0; S1 = dc1 * S1 + u1; } }
    }
    __syncthreads();
  }
}

constexpr int G3_QS = 0, G3_SS = 64 * G_LQ * 2, G3_OS = 0, G3_LO = 260;
__device__ __forceinline__ void ph_gla3(const Params& p, LAS char* lds) {
  const int tid = otid(), wid = tid >> 6, lane = tid & 63, fr = lane & 15, fq = lane >> 4;
  LAS bf16_t* Qs = (LAS bf16_t*)(lds + G3_QS); LAS bf16_t* Ss = (LAS bf16_t*)(lds + G3_SS); LAS float* Os = (LAS float*)(lds + G3_OS);
  u32x4 qv[2], sv[8];
  auto stage_load = [&](int uu) {
#pragma unroll
    for (int i = 0; i < 2; ++i) { const int pc = tid + i * 512, row = pc >> 4, cc = (pc & 15) * 8; qv[i] = *(const u32x4*)(p.qtil + ((size_t)uu * 64 + row) * 128 + cc); }
#pragma unroll
    for (int i = 0; i < 8; ++i) { const int pc = tid + i * 512, row = pc >> 4, cc = (pc & 15) * 8; sv[i] = *(const u32x4*)(p.st + ((size_t)uu * 256 + row) * 128 + cc); } };
  if ((int)blockIdx.x < 512) stage_load(blockIdx.x);
  for (int u = blockIdx.x; u < 512; u += gridDim.x) {
    const int b = u >> 7, h = (u >> 5) & 3, c = u & 31; const size_t t0 = (size_t)b * SEQ + c * 64;
#pragma unroll
    for (int i = 0; i < 2; ++i) { const int pc = tid + i * 512, row = pc >> 4, cc = (pc & 15) * 8; *(LAS u32x4*)(Qs + row * G_LQ + cc) = qv[i]; }
#pragma unroll
    for (int i = 0; i < 8; ++i) { const int pc = tid + i * 512, row = pc >> 4, cc = (pc & 15) * 8; *(LAS u32x4*)(Ss + row * G_LQ + cc) = sv[i]; }
    u32x2 obv[2][4]; u32x4 rrv[4];
    { const bf16_t* oi = p.oib + (size_t)u * 64 * 256;
#pragma unroll
      for (int q = 0; q < 2; ++q)
#pragma unroll
        for (int mt = 0; mt < 4; ++mt) obv[q][mt] = *(const u32x2*)(oi + (mt * 16 + fr) * 256 + (wid * 2 + q) * 16 + fq * 4);
      const bf16_t* rp0 = p.proj + (t0 + (tid >> 3)) * NP + 5120 + h * 256 + (tid & 7) * 32;
#pragma unroll
      for (int q = 0; q < 4; ++q) rrv[q] = *(const u32x4*)(rp0 + q * 8); }
    __syncthreads();
    if (u + (int)gridDim.x < 512) stage_load(u + gridDim.x);
    f32x4 res[2][4];
#pragma unroll
    for (int q = 0; q < 2; ++q) { const int nt = wid * 2 + q;
#pragma unroll
      for (int mt = 0; mt < 4; ++mt) { const f32x4 cc = mma_tile<4>(Ss + nt * 16 * G_LQ, G_LQ, Qs + mt * 16 * G_LQ, G_LQ, fr, fq);
        const u32x2 ob = obv[q][mt]; res[q][mt] = cc + (f32x4){bflo(ob.x), bfhi(ob.x), bflo(ob.y), bfhi(ob.y)}; } }
    __syncthreads();
#pragma unroll
    for (int q = 0; q < 2; ++q) { const int nt = wid * 2 + q;
#pragma unroll
      for (int mt = 0; mt < 4; ++mt) *(LAS f32x4*)(Os + (mt * 16 + fr) * G3_LO + nt * 16 + fq * 4) = res[q][mt]; }
    __syncthreads();
    { const int i = tid >> 3, seg = tid & 7; float v[32]; float ss = 0.f;
#pragma unroll
      for (int q = 0; q < 8; ++q) { const f32x4 x = *(const LAS f32x4*)(Os + i * G3_LO + seg * 32 + q * 4); v[q * 4] = x[0]; v[q * 4 + 1] = x[1]; v[q * 4 + 2] = x[2]; v[q * 4 + 3] = x[3]; ss += x[0] * x[0] + x[1] * x[1] + x[2] * x[2] + x[3] * x[3]; }
      ss += __shfl_xor(ss, 1); ss += __shfl_xor(ss, 2); ss += __shfl_xor(ss, 4);
      const float rstd = rsqrtf(ss * (1.0f / 256.0f) + 1e-6f);
      bf16_t* op = p.mix + (t0 + i) * DM + 1024 + h * 256 + seg * 32; const float* nw = p.gla_norm_w + seg * 32;
#pragma unroll
      for (int q = 0; q < 4; ++q) { const u32x4 rr = rrv[q]; const float rf[8] = {bflo(rr.x), bfhi(rr.x), bflo(rr.y), bfhi(rr.y), bflo(rr.z), bfhi(rr.z), bflo(rr.w), bfhi(rr.w)}; float o8[8];
#pragma unroll
        for (int j = 0; j < 8; ++j) { const float r = rf[j]; const float sl = r * __builtin_amdgcn_rcpf(1.0f + __expf(-r)); o8[j] = v[q * 8 + j] * rstd * nw[q * 8 + j] * sl; }
        u32x4 w; w.x = cvt_pk_bf16(o8[0], o8[1]); w.y = cvt_pk_bf16(o8[2], o8[3]); w.z = cvt_pk_bf16(o8[4], o8[5]); w.w = cvt_pk_bf16(o8[6], o8[7]); *(u32x4*)(op + q * 8) = w; } }
    __syncthreads();
  }
}

constexpr int SHM_KV = 64 * 128 * 2;
#define KSWZ(row, colB) ((row) * 256 + ((colB) ^ (((row) & 7) << 4)))
#define SBAR() __builtin_amdgcn_sched_barrier(0)
__device__ __forceinline__ int crow(int r, int hi) { return (r & 3) + 8 * (r >> 2) + 4 * hi; }
constexpr float ATT_THR = 14.0f;
template <bool FAST> __device__ __forceinline__ void partialSM(f32x16& p0, f32x16& p1, float& m_reg, float& mn, float& alpha) {
  if constexpr (FAST) {
#pragma unroll
    for (int r = 0; r < 16; ++r) p0[r] = __builtin_amdgcn_exp2f(p0[r]);
    return; }
  float pmax = p0[0];
#pragma unroll
  for (int r = 1; r < 16; ++r) pmax = fmaxf(pmax, p0[r]);
#pragma unroll
  for (int r = 0; r < 16; ++r) pmax = fmaxf(pmax, p1[r]);
  { auto rr = __builtin_amdgcn_permlane32_swap(__float_as_uint(pmax), __float_as_uint(pmax), false, false); pmax = fmaxf(__uint_as_float(rr[0]), __uint_as_float(rr[1])); }
  if (__builtin_expect(__all(pmax - m_reg <= ATT_THR), 1)) { mn = m_reg; alpha = 1.f; }
  else { mn = fmaxf(m_reg, pmax); alpha = __builtin_amdgcn_exp2f(m_reg - mn); m_reg = mn; }
#pragma unroll
  for (int r = 0; r < 16; ++r) p0[r] = p0[r] - mn;
#pragma unroll
  for (int r = 0; r < 16; ++r) p1[r] = p1[r] - mn;
#pragma unroll
  for (int r = 0; r < 16; ++r) p0[r] = __builtin_amdgcn_exp2f(p0[r]);
}
template <bool FAST> __device__ __forceinline__ void finishSM(f32x16& p0, f32x16& p1, float alpha, float& l_reg, bf16x8& pa0, bf16x8& pa1, bf16x8& pa2, bf16x8& pa3) {
#pragma unroll
  for (int r = 0; r < 16; ++r) p1[r] = __builtin_amdgcn_exp2f(p1[r]);
  float ps = 0;
#pragma unroll
  for (int r = 0; r < 16; ++r) ps += p0[r];
#pragma unroll
  for (int r = 0; r < 16; ++r) ps += p1[r];
  { auto rr = __builtin_amdgcn_permlane32_swap(__float_as_uint(ps), __float_as_uint(ps), false, false); ps = __uint_as_float(rr[0]) + __uint_as_float(rr[1]); }
  if constexpr (FAST) l_reg += ps; else l_reg = l_reg * alpha + ps;
#define PK4(P, BASE, OUT) do { unsigned a0 = cvt_pk_bf16(P[BASE + 0], P[BASE + 1]), a1 = cvt_pk_bf16(P[BASE + 2], P[BASE + 3]);   \
    unsigned b0 = cvt_pk_bf16(P[BASE + 4], P[BASE + 5]), b1 = cvt_pk_bf16(P[BASE + 6], P[BASE + 7]);                              \
    auto r0 = __builtin_amdgcn_permlane32_swap(a0, b0, false, false); auto r1 = __builtin_amdgcn_permlane32_swap(a1, b1, false, false); \
    u32x4 w = {r0[0], r1[0], r0[1], r1[1]}; OUT = *reinterpret_cast<bf16x8*>(&w); } while (0)
  PK4(p0, 0, pa0); PK4(p0, 8, pa1); PK4(p1, 0, pa2); PK4(p1, 8, pa3);
#undef PK4
}
__device__ __forceinline__ void qkt(f32x16& p0, f32x16& p1, const LAS char* Ks, const bf16x8* qr, int r32, int hi, int mapc) {
  p0 = f32x16{}; p1 = f32x16{};
#pragma unroll
  for (int d0 = 0; d0 < 4; ++d0) { const int cb = (mapc + d0 * 16 + hi * 8) * 2;
    const bf16x8 b0 = *(const LAS bf16x8*)(Ks + KSWZ(r32, cb));
    const bf16x8 b1 = *(const LAS bf16x8*)(Ks + KSWZ(32 + r32, cb));
    p0 = __builtin_amdgcn_mfma_f32_32x32x16_bf16(b0, qr[d0], p0, 0, 0, 0);
    p1 = __builtin_amdgcn_mfma_f32_32x32x16_bf16(b1, qr[d0], p1, 0, 0, 0); }
}
__device__ __forceinline__ int v_st(int k, int c) { const int kk = (k & ~0xC) | ((k & 4) << 1) | ((k & 8) >> 1); return ((kk >> 3) * 4 + (c >> 5)) * 512 + ((kk & 7) * 32 + (c & 31)) * 2; }
__device__ __forceinline__ int v_rd_base(int lane) { return ((lane & 3) << 3) | (((lane >> 2) & 3) << 6) | (((lane >> 4) & 1) << 5) | (((lane >> 5) & 1) << 8); }
constexpr int v_rd_off(int d0, int ks, int half) { return d0 * 512 + ks * 4096 + half * 2048; }
template <int OFF> __device__ __forceinline__ s16x4 tr_read(int vb) { s16x4 r; asm volatile("ds_read_b64_tr_b16 %0, %1 offset:%2" : "=&v"(r) : "v"(vb), "i"(OFF) : "memory"); return r; }
template <int D0> __device__ __forceinline__ void pv_one(f32x16& od, int vb, bf16x8 pa0, bf16x8 pa1, bf16x8 pa2, bf16x8 pa3) {
  const s16x4 l0 = tr_read<v_rd_off(D0, 0, 0)>(vb), h0 = tr_read<v_rd_off(D0, 0, 1)>(vb), l1 = tr_read<v_rd_off(D0, 1, 0)>(vb), h1 = tr_read<v_rd_off(D0, 1, 1)>(vb);
  const s16x4 l2 = tr_read<v_rd_off(D0, 2, 0)>(vb), h2 = tr_read<v_rd_off(D0, 2, 1)>(vb), l3 = tr_read<v_rd_off(D0, 3, 0)>(vb), h3 = tr_read<v_rd_off(D0, 3, 1)>(vb);
  asm volatile("s_waitcnt lgkmcnt(0)" ::: "memory"); SBAR();
#define PK(L, H) (bf16x8){L[0], L[1], L[2], L[3], H[0], H[1], H[2], H[3]}
  od = __builtin_amdgcn_mfma_f32_32x32x16_bf16(pa0, PK(l0, h0), od, 0, 0, 0);
  od = __builtin_amdgcn_mfma_f32_32x32x16_bf16(pa1, PK(l1, h1), od, 0, 0, 0);
  od = __builtin_amdgcn_mfma_f32_32x32x16_bf16(pa2, PK(l2, h2), od, 0, 0, 0);
  od = __builtin_amdgcn_mfma_f32_32x32x16_bf16(pa3, PK(l3, h3), od, 0, 0, 0);
#undef PK
}
__device__ __forceinline__ void pv_d0(f32x16* o, int vb, bf16x8 pa0, bf16x8 pa1, bf16x8 pa2, bf16x8 pa3) {
  pv_one<0>(o[0], vb, pa0, pa1, pa2, pa3); pv_one<1>(o[1], vb, pa0, pa1, pa2, pa3); pv_one<2>(o[2], vb, pa0, pa1, pa2, pa3); pv_one<3>(o[3], vb, pa0, pa1, pa2, pa3);
}

template <bool FAST> __device__ __forceinline__ void attn_unit(const Params& p, LAS char* lds, int b, int h, int qb, float lam) {
  const int tid = otid(), wid = __builtin_amdgcn_readfirstlane(tid >> 6), lane = tid & 63, r32 = lane & 31, hi = lane >> 5;
  const int map = wid >> 2, wq = wid & 3, mapc = map * 64;
  LAS char* V_lds = lds; LAS char* K_lds = lds + 3 * SHM_KV;
  LAS float* wsf = (LAS float*)(lds + 6 * SHM_KV) + wid * 64; LAS float* li_l = wsf; LAS float* al_l = wsf + 32;
  const int i0 = qb * 128, NT = 2 * qb + 2; const bool masked = (wq < 2);
  float m_reg = -1e30f, l_reg = 0; f32x16 o[4] = {}; bf16x8 qr[4];
  const bf16_t* Qw = p.proj + ((size_t)b * SEQ + i0 + wq * 32 + r32) * NP + h * 128 + mapc + hi * 8;
  {
    u32x4 qraw[4]; float qf[4][8]; float ss = 0.f;
#pragma unroll
    for (int d0 = 0; d0 < 4; ++d0) qraw[d0] = *(const u32x4*)(Qw + d0 * 16);
#pragma unroll
    for (int d0 = 0; d0 < 4; ++d0) { const u32x4 r = qraw[d0]; qf[d0][0] = bflo(r.x); qf[d0][1] = bfhi(r.x); qf[d0][2] = bflo(r.y); qf[d0][3] = bfhi(r.y); qf[d0][4] = bflo(r.z); qf[d0][5] = bfhi(r.z); qf[d0][6] = bflo(r.w); qf[d0][7] = bfhi(r.w);
#pragma unroll
      for (int j = 0; j < 8; ++j) ss += qf[d0][j] * qf[d0][j]; }
    ss += __shfl_xor(ss, 32);
    const float rs = rsqrtf(ss * (1.0f / 64.0f) + 1e-6f) * (0.125f * 1.4426950408889634f);
#pragma unroll
    for (int d0 = 0; d0 < 4; ++d0) { const f32x4 w0 = *(const f32x4*)(p.q_norm_w + d0 * 16 + hi * 8), w1 = *(const f32x4*)(p.q_norm_w + d0 * 16 + hi * 8 + 4);
      u32x4 o; o.x = cvt_pk_bf16(qf[d0][0] * rs * w0[0], qf[d0][1] * rs * w0[1]); o.y = cvt_pk_bf16(qf[d0][2] * rs * w0[2], qf[d0][3] * rs * w0[3]);
      o.z = cvt_pk_bf16(qf[d0][4] * rs * w1[0], qf[d0][5] * rs * w1[1]); o.w = cvt_pk_bf16(qf[d0][6] * rs * w1[2], qf[d0][7] * rs * w1[3]);
      qr[d0] = *reinterpret_cast<bf16x8*>(&o); } }
  const rsrc_t RK = mk_rsrc(p.proj + (size_t)b * SEQ * NP + 1024 + h * 128);
  const int sr = tid >> 4, sc = (tid & 15) * 8, vst0 = v_st(sr, sc), vst1 = v_st(32 + sr, sc); const unsigned soff = (unsigned)(sr * NP + sc) * 2u;
  const int vb0 = (int)(unsigned)(uintptr_t)V_lds + v_rd_base(lane);
  struct { bf16x8 vs0, vs1, ks0, ks1; } sr_[2];
#define BL128(so) ({ u32x4 _t = __builtin_amdgcn_raw_buffer_load_b128(RK, (int)soff, (int)(so), 0); *reinterpret_cast<bf16x8*>(&_t); })
#define SLOAD(i, k0) do { const unsigned _s0 = (unsigned)(k0) * (NP * 2), _s1 = _s0 + 32 * NP * 2; \
    sr_[i].vs0 = BL128(_s0 + 2048); sr_[i].vs1 = BL128(_s1 + 2048); sr_[i].ks0 = BL128(_s0); sr_[i].ks1 = BL128(_s1); } while (0)
#define SWRITE(off, i) do { *(LAS bf16x8*)(V_lds + (off) + vst0) = sr_[i].vs0; *(LAS bf16x8*)(V_lds + (off) + vst1) = sr_[i].vs1; const int kc = sc * 2; \
    *(LAS bf16x8*)(K_lds + (off) + KSWZ(sr, kc)) = sr_[i].ks0; *(LAS bf16x8*)(K_lds + (off) + KSWZ(32 + sr, kc)) = sr_[i].ks1; } while (0)
#define SWAIT() asm volatile("s_waitcnt vmcnt(4)" ::: "memory")
#define RESC(a) do { if constexpr (!FAST) if (__any((a) < 1.f)) { if (hi == 0) al_l[r32] = (a); asm volatile("s_waitcnt lgkmcnt(0)" ::: "memory"); \
    _Pragma("unroll") for (int d = 0; d < 4; ++d) _Pragma("unroll") for (int r = 0; r < 16; ++r) o[d][r] *= al_l[crow(r, hi)]; } } while (0)
  f32x16 pA0, pA1, pB0, pB1; float mnA = 0.f, mnB = 0.f, alA = 1.f, alB = 1.f; bf16x8 pa0, pa1, pa2, pa3;
  int offV = 0, offK = SHM_KV, offW = 2 * SHM_KV;
#define ROT3() do { const int _t = offV; offV = offK; offK = offW; offW = _t; } while (0)
  SLOAD(0, 0); asm volatile("s_waitcnt vmcnt(0)" ::: "memory"); SWRITE(0, 0); __syncthreads();
  qkt(pA0, pA1, K_lds, qr, r32, hi, mapc); partialSM<FAST>(pA0, pA1, m_reg, mnA, alA);
  SLOAD(1, 64); if (2 < NT) SLOAD(0, 128);
  SWAIT(); SWRITE(SHM_KV, 1); __syncthreads();
  for (int j = 1; j + 1 < NT; j += 2) {
    SBAR(); qkt(pB0, pB1, K_lds + offK, qr, r32, hi, mapc);
    finishSM<FAST>(pA0, pA1, alA, l_reg, pa0, pa1, pa2, pa3); SBAR();
    SLOAD(1, (j + 2) * 64); SBAR();
    pv_d0(o, vb0 + offV, pa0, pa1, pa2, pa3); partialSM<FAST>(pB0, pB1, m_reg, mnB, alB);
    SWAIT(); SWRITE(offW, 0);
    RESC(alB); __syncthreads(); ROT3();
    SBAR(); qkt(pA0, pA1, K_lds + offK, qr, r32, hi, mapc);
    finishSM<FAST>(pB0, pB1, alB, l_reg, pa0, pa1, pa2, pa3); SBAR();
    if (j + 3 < NT) SLOAD(0, (j + 3) * 64); SBAR();
    pv_d0(o, vb0 + offV, pa0, pa1, pa2, pa3); partialSM<FAST>(pA0, pA1, m_reg, mnA, alA);
    SWAIT(); SWRITE(offW, 1);
    RESC(alA); __syncthreads(); ROT3();
  }
  SBAR(); qkt(pB0, pB1, K_lds + offK, qr, r32, hi, mapc);
  if (masked) {
#pragma unroll
    for (int r = 0; r < 16; ++r) { pB0[r] = -1e30f; pB1[r] = -1e30f; } }
  finishSM<FAST>(pA0, pA1, alA, l_reg, pa0, pa1, pa2, pa3); SBAR();
  pv_d0(o, vb0 + offV, pa0, pa1, pa2, pa3); partialSM<FAST>(pB0, pB1, m_reg, mnB, alB);
  RESC(alB);
  finishSM<FAST>(pB0, pB1, alB, l_reg, pa0, pa1, pa2, pa3); SBAR();
  pv_d0(o, vb0 + offK, pa0, pa1, pa2, pa3);
#undef ROT3
  if (hi == 0) li_l[r32] = l_reg; asm volatile("s_waitcnt lgkmcnt(0)" ::: "memory");
  const float sgn = map ? -lam : 1.0f;
#pragma unroll
  for (int r = 0; r < 16; ++r) { const float rl = __builtin_amdgcn_rcpf(li_l[crow(r, hi)]) * sgn;
#pragma unroll
    for (int d = 0; d < 4; ++d) o[d][r] *= rl; }
  __syncthreads();
  LAS float* xch = (LAS float*)lds;
  if (map == 1) {
#pragma unroll
    for (int d = 0; d < 4; ++d)
#pragma unroll
      for (int r = 0; r < 16; ++r) xch[(wq * 64 + d * 16 + r) * 64 + lane] = o[d][r]; }
  __syncthreads();
  if (map == 0) {
    float subw[4];
#pragma unroll
    for (int d = 0; d < 4; ++d) subw[d] = p.subln_w[d * 32 + r32] * 0.8f;
#pragma unroll
    for (int r = 0; r < 16; ++r) { float ss = 0.f;
#pragma unroll
      for (int d = 0; d < 4; ++d) { o[d][r] += xch[(wq * 64 + d * 16 + r) * 64 + lane]; ss += o[d][r] * o[d][r]; }
      ss += __shfl_xor(ss, 1); ss += __shfl_xor(ss, 2); ss += __shfl_xor(ss, 4); ss += __shfl_xor(ss, 8); ss += __shfl_xor(ss, 16);
      const float rs = rsqrtf(ss * (1.0f / 128.0f) + 1e-6f);
#pragma unroll
      for (int d = 0; d < 4; ++d) xch[(wq * 64 + d * 16 + r) * 64 + lane] = o[d][r] * rs * subw[d]; }
  }
  __syncthreads();
#pragma unroll
  for (int it = 0; it < 4; ++it) { const int idx = it * 512 + tid, c8 = idx & 15, row = idx >> 4, wq2 = row >> 5, rho = row & 31;
    const int r = (rho & 3) + 4 * (rho >> 3), hi2 = (rho >> 2) & 1, d = c8 >> 2;
    const LAS float* src = xch + (wq2 * 64 + d * 16 + r) * 64 + hi2 * 32 + (c8 & 3) * 8;
    const f32x4 v0 = *(const LAS f32x4*)src, v1 = *(const LAS f32x4*)(src + 4);
    u32x4 w; w.x = cvt_pk_bf16(v0[0], v0[1]); w.y = cvt_pk_bf16(v0[2], v0[3]); w.z = cvt_pk_bf16(v1[0], v1[1]); w.w = cvt_pk_bf16(v1[2], v1[3]);
    *(u32x4*)(p.mix + ((size_t)b * SEQ + i0 + row) * DM + h * 128 + c8 * 8) = w; }
  __syncthreads();
#undef SLOAD
#undef BL128
#undef SWRITE
#undef SWAIT
#undef RESC
}
__device__ __forceinline__ void ph_attn(const Params& p, LAS char* lds) {
  const int lane = otid() & 63;
  const float s1 = wave_sum(p.lq1[lane] * p.lk1[lane]), s2 = wave_sum(p.lq2[lane] * p.lk2[lane]);
  const float lam = expf(s1) - expf(s2) + 0.2f;
  float mq = fabsf(p.q_norm_w[lane]), mk = fabsf(p.k_norm_w[lane]);
#pragma unroll
  for (int o = 1; o < 64; o <<= 1) { mq = fmaxf(mq, __shfl_xor(mq, o)); mk = fmaxf(mk, __shfl_xor(mk, o)); }
  const float bound = 64.0f * 0.125f * 1.4426950408889634f * 1.01f * mq * mk;
  const bool fast = __builtin_amdgcn_readfirstlane(bound <= 24.0f ? 1 : 0) != 0;
  for (int u = blockIdx.x; u < 256; u += gridDim.x) {
    const int b = u >> 6, h = (u >> 3) & 7, pq = u & 7;
    if (fast) { for (int hh = 0; hh < 2; ++hh) attn_unit<true>(p, lds, b, h, hh ? pq : 15 - pq, lam); }
    else { for (int hh = 0; hh < 2; ++hh) attn_unit<false>(p, lds, b, h, hh ? pq : 15 - pq, lam); }
  }
}

__device__ __forceinline__ void ph_outproj(const Params& p, LAS char* lds) {
  unsigned bo[2]; b_offsets<true>(bo);
  for (int u = blockIdx.x; u < 32 * 8; u += gridDim.x) {
    const int pm = u & 31, pn = u >> 5;
    unsigned ao[2][2];
#pragma unroll
    for (int h = 0; h < 2; ++h)
#pragma unroll
      for (int i = 0; i < 2; ++i) { int R, C; stage_rc(otid() * 16 + i * 8192, R, C); ao[h][i] = (unsigned)((pm * 256 + h * 128 + R) * KDIM + C) * 2u; }
    EpiProj E{p.hn, pm, pn, DM};
    gemm_unit(lds, mk_rsrc(p.mix), ao, mk_rsrc(p.wt_out + (size_t)(pn * 256) * KDIM), mk_rsrc(p.wt_out + (size_t)(pn * 256 + 128) * KDIM), bo, E);
    __syncthreads();
  }
}

__device__ __forceinline__ void ph_router(const Params& p, LAS char* lds) {
  const int tid = otid(), kq = tid >> 6, lane = tid & 63, fr = lane & 15, fq = lane >> 4;
  LAS float* ssq = (LAS float*)lds;
  LAS float* part = (LAS float*)(lds + 1024);
  for (int task = blockIdx.x; task < T_TOK / 32; task += gridDim.x) {
    f32x4 ha[2][8], hb[2][8];
#pragma unroll
    for (int rt = 0; rt < 2; ++rt) { const size_t ro = (size_t)(task * 32 + rt * 16 + fr) * DM + kq * 256 + fq * 8; const float* xr = p.x + ro; const bf16_t* ar = p.hn + ro;
#pragma unroll
      for (int ks = 0; ks < 8; ++ks) { const u32x4 av = *(const u32x4*)(ar + ks * 32);
        ha[rt][ks] = *(const f32x4*)(xr + ks * 32) + (f32x4){bflo(av.x), bfhi(av.x), bflo(av.y), bfhi(av.y)}; hb[rt][ks] = *(const f32x4*)(xr + ks * 32 + 4) + (f32x4){bflo(av.z), bfhi(av.z), bflo(av.w), bfhi(av.w)}; }
      __builtin_amdgcn_sched_barrier(0); }
#pragma unroll
    for (int rt = 0; rt < 2; ++rt) { float ss = 0.f;
#pragma unroll
      for (int ks = 0; ks < 8; ++ks) { const f32x4 a = ha[rt][ks], c = hb[rt][ks]; ss += a[0] * a[0] + a[1] * a[1] + a[2] * a[2] + a[3] * a[3] + c[0] * c[0] + c[1] * c[1] + c[2] * c[2] + c[3] * c[3]; }
      ss += __shfl_xor(ss, 16); ss += __shfl_xor(ss, 32);
      if (fq == 0) ssq[(rt * 8 + kq) * 16 + fr] = ss; }
    __syncthreads();
    float rstd[2];
#pragma unroll
    for (int rt = 0; rt < 2; ++rt) { float tot = 0.f;
#pragma unroll
      for (int q = 0; q < 8; ++q) tot += ssq[(rt * 8 + q) * 16 + fr];
      rstd[rt] = rsqrtf(tot * (1.0f / 2048.0f) + 1e-6f); }
    f32x4 acc[2][2];
#pragma unroll
    for (int rt = 0; rt < 2; ++rt) { acc[rt][0] = (f32x4){0.f, 0.f, 0.f, 0.f}; acc[rt][1] = (f32x4){0.f, 0.f, 0.f, 0.f}; }
    const bf16_t* wh0 = p.wr_hi + fr * 2048 + kq * 256 + fq * 8; const bf16_t* wl0 = p.wr_lo + fr * 2048 + kq * 256 + fq * 8;
    const float* nwp = p.ffn_norm_w + kq * 256 + fq * 8;
#pragma unroll
    for (int ks = 0; ks < 8; ++ks) {
      const f32x4 wa = *(const f32x4*)(nwp + ks * 32), wc = *(const f32x4*)(nwp + ks * 32 + 4);
      const bf16x8 bh0 = *(const bf16x8*)(wh0 + ks * 32), bh1 = *(const bf16x8*)(wh0 + 16 * 2048 + ks * 32), bl0 = *(const bf16x8*)(wl0 + ks * 32), bl1 = *(const bf16x8*)(wl0 + 16 * 2048 + ks * 32);
#pragma unroll
      for (int rt = 0; rt < 2; ++rt) {
        const f32x4 a = ha[rt][ks], c = hb[rt][ks]; const float rs = rstd[rt];
        float t[8] = {a[0] * rs * wa[0], a[1] * rs * wa[1], a[2] * rs * wa[2], a[3] * rs * wa[3], c[0] * rs * wc[0], c[1] * rs * wc[1], c[2] * rs * wc[2], c[3] * rs * wc[3]};
        u32x4 hi4, lo4;
        hi4.x = cvt_pk_bf16(t[0], t[1]); hi4.y = cvt_pk_bf16(t[2], t[3]); hi4.z = cvt_pk_bf16(t[4], t[5]); hi4.w = cvt_pk_bf16(t[6], t[7]);
        lo4.x = cvt_pk_bf16(t[0] - bflo(hi4.x), t[1] - bfhi(hi4.x)); lo4.y = cvt_pk_bf16(t[2] - bflo(hi4.y), t[3] - bfhi(hi4.y));
        lo4.z = cvt_pk_bf16(t[4] - bflo(hi4.z), t[5] - bfhi(hi4.z)); lo4.w = cvt_pk_bf16(t[6] - bflo(hi4.w), t[7] - bfhi(hi4.w));
        *(u32x4*)(p.tb + (size_t)(task * 32 + rt * 16 + fr) * DM + kq * 256 + fq * 8 + ks * 32) = hi4;
        const bf16x8 ah = *reinterpret_cast<bf16x8*>(&hi4), al = *reinterpret_cast<bf16x8*>(&lo4);
        acc[rt][0] = __builtin_amdgcn_mfma_f32_16x16x32_bf16(ah, bh0, acc[rt][0], 0, 0, 0); acc[rt][0] = __builtin_amdgcn_mfma_f32_16x16x32_bf16(ah, bl0, acc[rt][0], 0, 0, 0); acc[rt][0] = __builtin_amdgcn_mfma_f32_16x16x32_bf16(al, bh0, acc[rt][0], 0, 0, 0);
        acc[rt][1] = __builtin_amdgcn_mfma_f32_16x16x32_bf16(ah, bh1, acc[rt][1], 0, 0, 0); acc[rt][1] = __builtin_amdgcn_mfma_f32_16x16x32_bf16(ah, bl1, acc[rt][1], 0, 0, 0); acc[rt][1] = __builtin_amdgcn_mfma_f32_16x16x32_bf16(al, bh1, acc[rt][1], 0, 0, 0);
      }
    }
#pragma unroll
    for (int rt = 0; rt < 2; ++rt) { LAS float* pw_ = part + (rt * 8 + kq) * (16 * 33);
#pragma unroll
      for (int r = 0; r < 4; ++r) { pw_[(fq * 4 + r) * 33 + fr] = acc[rt][0][r]; pw_[(fq * 4 + r) * 33 + 16 + fr] = acc[rt][1][r]; } }
    __syncthreads();
    if (kq < 2 && lane < 16) { const int rt = kq;
      float v[32]; const LAS float* pr_ = part + (rt * 8) * (16 * 33) + lane * 33;
#pragma unroll
      for (int e = 0; e < 32; ++e) { float sacc = p.router_b[e];
#pragma unroll
        for (int q = 0; q < 8; ++q) sacc += pr_[q * 16 * 33 + e];
        v[e] = sacc; }
      float tv[4]; int ti[4];
#pragma unroll
      for (int k = 0; k < 4; ++k) { float best = -3.0e38f; int bi = 0;
#pragma unroll
        for (int e = 0; e < 32; ++e) { if (v[e] > best) { best = v[e]; bi = e; } }
        tv[k] = best; ti[k] = bi;
#pragma unroll
        for (int e = 0; e < 32; ++e) v[e] = (e == bi) ? -3.0e38f : v[e]; }
      const float e1 = expf(tv[1] - tv[0]), e2 = expf(tv[2] - tv[0]), e3 = expf(tv[3] - tv[0]); const float inv = 1.0f / (1.0f + e1 + e2 + e3);
      const float wk[4] = {inv, e1 * inv, e2 * inv, e3 * inv};
      const int tok = task * 32 + rt * 16 + lane;
#pragma unroll
      for (int k = 0; k < 4; ++k) { const unsigned slot = __hip_atomic_fetch_add(p.cnt + ti[k], 1u, __ATOMIC_RELAXED, __HIP_MEMORY_SCOPE_AGENT);
        p.list[ti[k] * CAP + (int)slot] = tok * 4 + k; p.pw[tok * 4 + k] = wk[k]; }
    }
    __syncthreads();
  }
}

struct MoeTab { int cnt[32]; int base[33]; };
template <int NPL> __device__ __forceinline__ void moe_table(const Params& p, LAS MoeTab* tb) {
  if (otid() < 32) tb->cnt[otid()] = (int)__hip_atomic_load(p.cnt + otid(), __ATOMIC_RELAXED, __HIP_MEMORY_SCOPE_AGENT);
  __syncthreads();
  if (otid() == 0) { int s = 0; for (int e = 0; e < 32; ++e) { tb->base[e] = s; s += ((tb->cnt[e] + 255) >> 8) * NPL; } tb->base[32] = s; }
  __syncthreads();
}
struct EpiAct { rsrc_t RO; const LAS float* biasS; const LAS int* pairS; int pn;
  __device__ __forceinline__ void init(f32x4 (&acc)[2][2][4][2], int wc, int fq) const {
    const int cl = wc * 32 + 4 * fq;
#pragma unroll
    for (int bj = 0; bj < 2; ++bj)
#pragma unroll
      for (int n = 0; n < 2; ++n) { const f32x4 bv = *(const LAS f32x4*)(biasS + bj * 128 + cl + n * 16);
#pragma unroll
        for (int ai = 0; ai < 2; ++ai)
#pragma unroll
          for (int m = 0; m < 4; ++m) acc[ai][bj][m][n] = bv; }
  }
  template <int AI, int M0, int M1> __device__ __forceinline__ void part(const f32x4 (&acc)[2][2][4][2], int wr, int wc, int fr, int fq) const {
    const int odd = fq & 1, cs = pn * 128 + wc * 32 + (odd ? 16 : 0) + 8 * (fq >> 1);
    { constexpr int ai = AI;
#pragma unroll
      for (int m = M0; m < M1; ++m) { const int pr = pairS[ai * 128 + wr * 64 + m * 16 + fr];
        if (!__any(pr >= 0)) continue;
        u32x2 wq[2];
#pragma unroll
        for (int n = 0; n < 2; ++n) {
          f32x4 g = acc[ai][0][m][n], uu = acc[ai][1][m][n], e;
#pragma unroll
          for (int j = 0; j < 4; ++j) { g[j] = __builtin_amdgcn_fmed3f(g[j], -__builtin_inff(), 7.0f); uu[j] = __builtin_amdgcn_fmed3f(uu[j], -7.0f, 7.0f); }
          const f32x4 ta = g * (-1.702f * 1.4426950408889634f);
#pragma unroll
          for (int j = 0; j < 4; ++j) e[j] = __builtin_amdgcn_exp2f(ta[j]);
          e = e + 1.0f;
#pragma unroll
          for (int j = 0; j < 4; ++j) e[j] = __builtin_amdgcn_rcpf(e[j]);
          const f32x4 r4 = (uu + 1.0f) * g * e;
          wq[n].x = cvt_pk_bf16(r4[0], r4[1]); wq[n].y = cvt_pk_bf16(r4[2], r4[3]); }
        u32x4 w; quad_pair16(wq[0], wq[1], odd, w);
        if (pr >= 0) __builtin_amdgcn_raw_buffer_store_b128(w, RO, (unsigned)(pr * DM + cs) * 2u, 0, 16); } }
  } };
struct EpiY { bf16_t* O; const LAS float* biasS; const LAS float* pwS; const LAS int* pairS; int pn;
  __device__ __forceinline__ void init(f32x4 (&acc)[2][2][4][2], int wc, int fq) const {
    const int cl = wc * 32 + 4 * fq;
#pragma unroll
    for (int bj = 0; bj < 2; ++bj)
#pragma unroll
      for (int n = 0; n < 2; ++n) { const f32x4 bv = *(const LAS f32x4*)(biasS + cl + bj * 128 + n * 16);
#pragma unroll
        for (int ai = 0; ai < 2; ++ai)
#pragma unroll
          for (int m = 0; m < 4; ++m) acc[ai][bj][m][n] = bv; }
  }
  template <int AI, int M0, int M1> __device__ __forceinline__ void part(const f32x4 (&acc)[2][2][4][2], int wr, int wc, int fr, int fq) const {
    const int odd = fq & 1, cs = pn * 256 + wc * 32 + (odd ? 16 : 0) + 8 * (fq >> 1);
    { constexpr int ai = AI;
#pragma unroll
      for (int m = M0; m < M1; ++m) { const int rl = ai * 128 + wr * 64 + m * 16 + fr; const int pr = pairS[rl]; const float wgt = pwS[rl];
        if (!__any(pr >= 0)) continue;
#pragma unroll
        for (int bj = 0; bj < 2; ++bj) { u32x2 wq[2];
#pragma unroll
          for (int n = 0; n < 2; ++n) { const f32x4 v0 = acc[ai][bj][m][n] * wgt; wq[n].x = cvt_pk_bf16(v0[0], v0[1]); wq[n].y = cvt_pk_bf16(v0[2], v0[3]); }
          u32x4 w; quad_pair16(wq[0], wq[1], odd, w);
          if (pr >= 0) *(u32x4*)(O + (size_t)pr * DM + cs + bj * 128) = w; } } }
  } };
__device__ __forceinline__ void ph_moe_all(const Params& p, LAS char* lds) {
  LAS MoeTab* tb = (LAS MoeTab*)(lds + LDS_MISC); LAS int* pairS = (LAS int*)(lds + LDS_PAIR); LAS int* qS = (LAS int*)(lds + LDS_MISC + 512);
  moe_table<1>(p, tb);
  const int Mt = __builtin_amdgcn_readfirstlane(tb->base[32]), total = 3 * Mt;
  const int xl = blockIdx.x & 7;
  unsigned* qh = p.bar + CW_QHEAD + 16 * xl; unsigned* tmo = p.bar + CW_TMO;
  if (otid() == 0) qS[0] = (int)__hip_atomic_fetch_add(qh, 1u, __ATOMIC_RELAXED, __HIP_MEMORY_SCOPE_AGENT);
  __syncthreads();
  for (;;) {
    const int ent = __builtin_amdgcn_readfirstlane(qS[0]);
    if (ent >= total) break;
    unsigned nxt = 0u;
    if (otid() == 0) nxt = __hip_atomic_fetch_add(qh, 1u, __ATOMIC_RELAXED, __HIP_MEMORY_SCOPE_AGENT);
    const int which = ent >= 2 * Mt ? 1 : 0, idx0 = which ? ent - 2 * Mt : ent, npl = which ? 1 : 2;
    const int lq = otid() & 31;
    const unsigned long long bal = __ballot(idx0 >= tb->base[lq] * npl);
    const int e = __builtin_amdgcn_readfirstlane(__popcll(bal & 0xffffffffull) - 1);
    const int ce = __builtin_amdgcn_readfirstlane(tb->cnt[e]), mte = (ce + 255) >> 8, idx = idx0 - __builtin_amdgcn_readfirstlane(tb->base[e]) * npl, pnl = idx / mte, mt = idx - pnl * mte, pn = xl + 8 * pnl;
    unsigned* dn = p.bar + CW_DONE + 16 * (e * 32 + mt);
    if (which && otid() < 64) {
      unsigned sp = 0;
      while (__builtin_amdgcn_readfirstlane(__hip_atomic_load(dn, __ATOMIC_RELAXED, __HIP_MEMORY_SCOPE_AGENT)) < 16u) { __builtin_amdgcn_s_sleep(2);
        if ((++sp & 255u) == 0u) { if (__hip_atomic_load(tmo, __ATOMIC_RELAXED, __HIP_MEMORY_SCOPE_AGENT)) break; if (sp > (1u << 20)) { atomicAdd(tmo, 1u); break; } } }
      __builtin_amdgcn_fence(__ATOMIC_ACQUIRE, "agent");
      asm volatile("s_waitcnt vmcnt(0)" ::: "memory");
    }
    LAS float* biasS = (LAS float*)(lds + LDS_MISC + 1024); LAS float* pwS = (LAS float*)(lds + LDS_MISC + 2048);
    if (otid() < 256) { const int r = mt * 256 + otid(); const int pr = (r < ce) ? p.list[e * CAP + r] : -1; pairS[otid()] = pr; if (which) pwS[otid()] = pr >= 0 ? p.pw[pr] : 0.f; }
    else { const int c = otid() - 256;
      biasS[c] = which ? p.bd[e * 2048 + pn * 256 + c] : (c < 128 ? p.bg[e * 2048 + pn * 128 + c] : p.bu[e * 2048 + pn * 128 + c - 128]); }
    __syncthreads();
    unsigned ao[2][2];
#pragma unroll
    for (int h = 0; h < 2; ++h)
#pragma unroll
      for (int i = 0; i < 2; ++i) { int R, C; stage_rc(otid() * 16 + i * 8192, R, C); const int pr = pairS[h * 128 + R];
        ao[h][i] = pr < 0 ? 0x80000000u : (unsigned)((which ? pr : (pr >> 2)) * KDIM + C) * 2u; }
    const size_t eo = (size_t)e * 2048 * 2048;
    const bool half = (ce - mt * 256) <= 128;
    if (which == 0) { EpiAct E{mk_rsrc(p.act), biasS, pairS, pn};
      if (half) gemm_unit_f32b<true>(lds, mk_rsrc(p.tb), ao, mk_rsrc(p.wg + eo + pn * 128), mk_rsrc(p.wu + eo + pn * 128), E);
      else gemm_unit_f32b<false>(lds, mk_rsrc(p.tb), ao, mk_rsrc(p.wg + eo + pn * 128), mk_rsrc(p.wu + eo + pn * 128), E); }
    else { EpiY E{p.y, biasS, pwS, pairS, pn};
      if (half) gemm_unit_f32b<true>(lds, mk_rsrc(p.act), ao, mk_rsrc(p.wd + eo + pn * 256), mk_rsrc(p.wd + eo + pn * 256 + 128), E);
      else gemm_unit_f32b<false>(lds, mk_rsrc(p.act), ao, mk_rsrc(p.wd + eo + pn * 256), mk_rsrc(p.wd + eo + pn * 256 + 128), E); }
    if (which == 0) asm volatile("s_waitcnt vmcnt(0)" ::: "memory");
    __syncthreads();
    if (otid() == 0) { if (which == 0) __hip_atomic_fetch_add(dn, 1u, __ATOMIC_RELAXED, __HIP_MEMORY_SCOPE_AGENT); qS[0] = (int)nxt; }
    __syncthreads();
  }
}

__device__ __forceinline__ void ph_combine(const Params& p) {
  for (int g0 = blockIdx.x * 512 + otid(); g0 < T_TOK * 256; g0 += gridDim.x * 1024) {
    f32x4 a[2], b[2]; u32x4 av[2], y[2][4];
#pragma unroll
    for (int z = 0; z < 2; ++z) { int g = g0 + z * gridDim.x * 512; g = g < T_TOK * 256 ? g : g0; const size_t eo = (size_t)g * 8; const int t = g >> 8, c8 = (g & 255) * 8;
      a[z] = *(const f32x4*)(p.x + eo); b[z] = *(const f32x4*)(p.x + eo + 4); av[z] = *(const u32x4*)(p.hn + eo);
#pragma unroll
      for (int k = 0; k < 4; ++k) y[z][k] = *(const u32x4*)(p.y + (size_t)(t * 4 + k) * DM + c8); }
#pragma unroll
    for (int z = 0; z < 2; ++z) { int g = g0 + z * gridDim.x * 512; g = g < T_TOK * 256 ? g : g0; f32x4 aa = a[z], bb = b[z];
      aa[0] += bflo(av[z].x); aa[1] += bfhi(av[z].x); aa[2] += bflo(av[z].y); aa[3] += bfhi(av[z].y); bb[0] += bflo(av[z].z); bb[1] += bfhi(av[z].z); bb[2] += bflo(av[z].w); bb[3] += bfhi(av[z].w);
#pragma unroll
      for (int k = 0; k < 4; ++k) { const u32x4 yy = y[z][k];
        aa[0] += bflo(yy.x); aa[1] += bfhi(yy.x); aa[2] += bflo(yy.y); aa[3] += bfhi(yy.y); bb[0] += bflo(yy.z); bb[1] += bfhi(yy.z); bb[2] += bflo(yy.w); bb[3] += bfhi(yy.w); }
      float* op = p.out + (size_t)g * 8; *(f32x4*)op = aa; *(f32x4*)(op + 4) = bb; }
  }
}

template <int PH> __device__ __forceinline__ void run_phase(const Params& p, LAS char* lds) {
  if constexpr (PH == 0) { ph_norm_gd(p, lds); ph_convert(p, lds); }
  if constexpr (PH == 1) { ph_inproj(p, lds); ph_gdown(p, lds); }
  if constexpr (PH == 2) { ph_gla1(p, lds); if (PROBE & 128) ph_gla1(p, lds); }
  if constexpr (PH == 3) ph_gla_scan(p, lds);
  if constexpr (PH == 4) { ph_gla3(p, lds); if (PROBE & 256) ph_gla3(p, lds); ph_attn(p, lds); if (PROBE & 512) ph_attn(p, lds); }
  if constexpr (PH == 5) ph_outproj(p, lds);
  if constexpr (PH == 6) ph_router(p, lds);
  if constexpr (PH == 7) ph_moe_all(p, lds);
  if constexpr (PH == 9) ph_combine(p);
}
extern __shared__ __attribute__((aligned(16))) char smem_raw[];
#if !FUSED
template <int PH> __global__ void __launch_bounds__(512, 2) k_phase(Params p) {
  LAS char* lds = (LAS char*)smem_raw;
  run_phase<PH>(p, lds);
}
#else
typedef const __attribute__((address_space(4))) Params* KArgP;
__device__ __forceinline__ Params load_params(KArgP k) { Params q; q.x = k->x; q.attn_norm_w = k->attn_norm_w; q.w_in = k->w_in; q.q_norm_w = k->q_norm_w; q.k_norm_w = k->k_norm_w; q.lq1 = k->lq1; q.lk1 = k->lk1; q.lq2 = k->lq2; q.lk2 = k->lk2; q.subln_w = k->subln_w; q.gate_up_w = k->gate_up_w; q.gate_up_b = k->gate_up_b; q.gla_norm_w = k->gla_norm_w; q.w_out = k->w_out; q.ffn_norm_w = k->ffn_norm_w; q.router_w = k->router_w; q.router_b = k->router_b; q.wg = k->wg; q.bg = k->bg; q.wu = k->wu; q.bu = k->bu; q.wd = k->wd; q.bd = k->bd; q.out = k->out; q.bar = k->bar; q.cnt = k->cnt; q.wt_in = k->wt_in; q.wt_out = k->wt_out; q.wgd_hi = k->wgd_hi; q.wgd_lo = k->wgd_lo; q.hn = k->hn; q.proj = k->proj; q.mix = k->mix; q.qtil = k->qtil; q.st = k->st; q.tb = k->tb; q.wr_hi = k->wr_hi; q.wr_lo = k->wr_lo; q.act = k->act; q.y = k->y; q.gd = k->gd; q.decay = k->decay; q.pw = k->pw; q.oib = k->oib; q.Ub = k->Ub; q.list = k->list; return q; }
#define RUN(PHX) do { KArgP kp_ = kp0; asm volatile("" : "+s"(kp_)); const Params q_ = load_params(kp_); run_phase<PHX>(q_, lds); } while (0)
__global__ void __launch_bounds__(512, 2) k_fused(Params p) {
  LAS char* lds = (LAS char*)smem_raw;
  const KArgP kp0 = (KArgP)__builtin_amdgcn_kernarg_segment_ptr();
  volatile LAS unsigned* xbw = (volatile LAS unsigned*)(lds + LDS_BYTES - 16);
  if (threadIdx.x == 0) { xbw[0] = 0u; xbw[1] = 0u; xbw[2] = 0u; xbw[3] = 0u; }
  __syncthreads();
  XcdBarrier bar = xcd_barrier_post(p.bar, xbw);
#define DUP(PHX, MASK) if (PROBE & (MASK)) { RUN(PHX); xcd_barrier(bar); }
  RUN(0); xcd_barrier(bar); DUP(0, 1)
  RUN(1); xcd_barrier(bar); DUP(1, 2)
  RUN(2); xcd_barrier(bar);
  RUN(3); xcd_barrier(bar); DUP(3, 4)
  RUN(4); xcd_barrier(bar); DUP(4, 8)
  RUN(5); xcd_barrier(bar); DUP(5, 16)
  RUN(6); xcd_barrier(bar);
  RUN(7); xcd_barrier(bar);
  RUN(9);
#undef DUP
#undef RUN
}
#endif

static size_t carve(size_t& off, size_t bytes) { const size_t o = off; off = (off + bytes + 255) & ~(size_t)255; return o; }

#if !FUSED
template <int PH> static void launch_phase(const Params& p, int grid, hipStream_t s) {
  static bool set = false;
  if (!set) { (void)hipFuncSetAttribute((const void*)k_phase<PH>, hipFuncAttributeMaxDynamicSharedMemorySize, LDS_BYTES); set = true; }
  hipLaunchKernelGGL(k_phase<PH>, dim3(grid), dim3(512), LDS_BYTES, s, p);
}
#endif

extern "C" void kernel_launch(void* const* d_in, const int* in_sizes, int n_in, void* d_out, int out_size, void* d_ws, size_t ws_size, hipStream_t stream) {
  (void)in_sizes; (void)n_in; (void)out_size;
  Params p{};
  const float* const* in = (const float* const*)d_in;
  p.x = in[0]; p.attn_norm_w = in[1]; p.w_in = in[2]; p.q_norm_w = in[3]; p.k_norm_w = in[4]; p.lq1 = in[5]; p.lk1 = in[6]; p.lq2 = in[7]; p.lk2 = in[8];
  p.subln_w = in[9]; p.gate_up_w = in[10]; p.gate_up_b = in[11]; p.gla_norm_w = in[12]; p.w_out = in[13]; p.ffn_norm_w = in[14]; p.router_w = in[15]; p.router_b = in[16];
  p.wg = in[17]; p.bg = in[18]; p.wu = in[19]; p.bu = in[20]; p.wd = in[21]; p.bd = in[22];
  p.out = (float*)d_out;
  char* ws = (char*)d_ws; size_t off = 0;
  const size_t ctl = carve(off, CTL_BYTES);
  p.bar = (unsigned*)(ws + ctl); p.cnt = p.bar + CW_CNT;
  const size_t WSZ = (size_t)2048 * 2048 * 2;
  p.wt_in = (bf16_t*)(ws + carve(off, (size_t)NP * 2048 * 2));
  p.wt_out = (bf16_t*)(ws + carve(off, WSZ));
  p.wgd_hi = (bf16_t*)(ws + carve(off, 16 * 2048 * 2)); p.wgd_lo = (bf16_t*)(ws + carve(off, 16 * 2048 * 2));
  p.hn = (bf16_t*)(ws + carve(off, (size_t)T_TOK * DM * 2));
  p.proj = (bf16_t*)(ws + carve(off, (size_t)T_TOK * NP * 2));
  p.mix = (bf16_t*)(ws + carve(off, (size_t)T_TOK * DM * 2));
  p.qtil = (bf16_t*)(ws + carve(off, (size_t)512 * 64 * 128 * 2));
  p.st = (bf16_t*)(ws + carve(off, (size_t)512 * 256 * 128 * 2));
  p.tb = (bf16_t*)(ws + carve(off, (size_t)T_TOK * DM * 2));
  p.wr_hi = (bf16_t*)(ws + carve(off, 32 * 2048 * 2)); p.wr_lo = (bf16_t*)(ws + carve(off, 32 * 2048 * 2));
  p.act = (bf16_t*)(ws + carve(off, (size_t)T_TOK * 4 * DM * 2));
  p.y = (bf16_t*)(ws + carve(off, (size_t)T_TOK * 4 * DM * 2));
  p.gd = (float*)(ws + carve(off, (size_t)T_TOK * 16 * 4));
  p.oib = (bf16_t*)(ws + carve(off, (size_t)512 * 64 * 256 * 2));
  p.Ub = (bf16_t*)(ws + carve(off, (size_t)512 * 256 * 128 * 2));
  p.decay = (float*)(ws + carve(off, 512 * 128 * 4));
  p.pw = (float*)(ws + carve(off, (size_t)T_TOK * 4 * 4));
  p.list = (int*)(ws + carve(off, (size_t)NEXP * CAP * 4));
  if (off > ws_size) { fprintf(stderr, "kernel_launch: workspace too small: need %zu have %zu\n", off, ws_size); return; }
  static int grid = 0;
  if (!grid) { int dev = 0, cus = 0; (void)hipGetDevice(&dev); (void)hipDeviceGetAttribute(&cus, hipDeviceAttributeMultiprocessorCount, dev); grid = cus > 0 ? cus : 256; }
  (void)hipMemsetAsync(ws + ctl, 0, CTL_BYTES, stream);
#if !FUSED
  launch_phase<0>(p, grid, stream); launch_phase<1>(p, grid, stream); launch_phase<2>(p, grid, stream); launch_phase<3>(p, grid, stream); launch_phase<4>(p, grid, stream);
  launch_phase<5>(p, grid, stream); launch_phase<6>(p, grid, stream); launch_phase<7>(p, grid, stream); launch_phase<8>(p, grid, stream); launch_phase<9>(p, grid, stream);
#else
  static bool set = false;
  if (!set) {
    (void)hipFuncSetAttribute((const void*)k_fused, hipFuncAttributeMaxDynamicSharedMemorySize, LDS_BYTES);
    int per_cu = 0;
    if (hipOccupancyMaxActiveBlocksPerMultiprocessor(&per_cu, (const void*)k_fused, 512, LDS_BYTES) != hipSuccess || per_cu < 1)
      fprintf(stderr, "kernel_launch: occupancy query reports %d workgroups per CU\n", per_cu);
    set = true;
  }
  hipLaunchKernelGGL(k_fused, dim3(grid), dim3(512), LDS_BYTES, stream, p);
#endif
  const hipError_t le = hipPeekAtLastError();
  if (le != hipSuccess) fprintf(stderr, "kernel_launch: launch failed: %s\n", hipGetErrorName(le));
}
```

```cpp
#include <hip/hip_runtime.h>
#include <stdint.h>
#include <stdio.h>

#ifndef FUSED
#define FUSED 1
#endif
#define PROBE 0

#define LAS __attribute__((address_space(3)))
typedef unsigned short bf16_t;
typedef short bf16x8 __attribute__((ext_vector_type(8)));
typedef short s16x4 __attribute__((ext_vector_type(4)));
typedef float f32x4 __attribute__((ext_vector_type(4)));
typedef float f32x16 __attribute__((ext_vector_type(16)));
typedef unsigned u32x4 __attribute__((ext_vector_type(4)));
typedef unsigned u32x2 __attribute__((ext_vector_type(2)));

constexpr int T_TOK = 8192, DM = 2048, NP = 6144, LDW = 6160, SEQ = 2048;
constexpr int NEXP = 32, CAP = 8192;
constexpr int LDS_BYTES = 147456;
constexpr int LDS_PAIR = 131072;
constexpr int LDS_MISC = 131072 + 1024;
constexpr int CW_CNT = 3456, CW_QHEAD = 3520, CW_TMO = 3712, CW_DONE = 4096;
constexpr int CTL_BYTES = (4096 + 32 * 32 * 16) * 4;

__device__ __forceinline__ unsigned cvt_pk_bf16(float lo, float hi) { unsigned r; asm("v_cvt_pk_bf16_f32 %0, %1, %2" : "=v"(r) : "v"(lo), "v"(hi)); return r; }
__device__ __forceinline__ float bf2f(bf16_t b) { return __uint_as_float(((unsigned)b) << 16); }
__device__ __forceinline__ float bflo(unsigned w) { return __uint_as_float(w << 16); }
__device__ __forceinline__ float bfhi(unsigned w) { return __uint_as_float(w & 0xffff0000u); }
__device__ __forceinline__ bf16_t f2bf(float f) { return (bf16_t)(cvt_pk_bf16(f, 0.f) & 0xffffu); }
__device__ __forceinline__ float wave_sum(float v) {
#pragma unroll
  for (int o = 32; o >= 1; o >>= 1) v += __shfl_xor(v, o);
  return v;
}

typedef __bf16 cbf2 __attribute__((ext_vector_type(2)));
typedef float cf2 __attribute__((ext_vector_type(2)));
__device__ __forceinline__ unsigned pkc(float a, float b) { cf2 v = {a, b}; cbf2 r = __builtin_convertvector(v, cbf2); return *reinterpret_cast<unsigned*>(&r); }
__device__ __forceinline__ void quad_pair16(const u32x2 w0, const u32x2 w1, const int odd, u32x4& out) {
  const unsigned sx = odd ? w0.x : w1.x, sy = odd ? w0.y : w1.y;
  const unsigned rx = (unsigned)__shfl_xor((int)sx, 16), ry = (unsigned)__shfl_xor((int)sy, 16);
  out = odd ? (u32x4){rx, ry, w1.x, w1.y} : (u32x4){w0.x, w0.y, rx, ry};
}
__device__ __forceinline__ int otid() { int t = threadIdx.x; asm volatile("" : "+v"(t)); return t; }
#define XB_TMO      128
#define XB_XCNT(j)  (256  + 64 * (j))
#define XB_XSUB(j)  (1280 + 64 * (j))
#define XB_XGEN(j)  (2304 + 64 * (j))
#define XB_TOP      3328
#define XB_TOPGEN   3392
#define XCD_BAR_WORDS 3456
#define XB_SPIN_CAP (1u << 18)
__device__ __forceinline__ unsigned xb_ld(unsigned* p)              { return __hip_atomic_load(p, __ATOMIC_RELAXED, __HIP_MEMORY_SCOPE_AGENT); }
__device__ __forceinline__ unsigned xb_add(unsigned* p, unsigned v) { return __hip_atomic_fetch_add(p, v, __ATOMIC_RELAXED, __HIP_MEMORY_SCOPE_AGENT); }
__device__ __forceinline__ unsigned xb_xcc_id() { return (unsigned)__builtin_amdgcn_s_getreg((3 << 11) | 20) & 0xFu; }
#define XB_SPIN(cond, bar) do { unsigned _sp = 0; while (cond) { __builtin_amdgcn_s_sleep(1); \
    if ((++_sp & 255u) == 0u) { if (xb_ld(&(bar)[XB_TMO])) break; if (_sp > XB_SPIN_CAP) { atomicAdd(&(bar)[XB_TMO], 1u); break; } } } } while (0)
struct XcdBarrier { unsigned* bar; unsigned x; volatile LAS unsigned* st; };
__device__ __forceinline__ XcdBarrier xcd_barrier_post(unsigned* bar, volatile LAS unsigned* st) {
    XcdBarrier b; b.bar = bar; b.x = xb_xcc_id(); b.st = st;
    if (threadIdx.x == 0) (void)xb_add(&bar[XB_XCNT(b.x)], 1u);
    return b;
}
__device__ __forceinline__ void xcd_barrier_complete(unsigned* bar, unsigned x, unsigned& nloc, unsigned& nx) {
    const unsigned G = gridDim.x * gridDim.y * gridDim.z;
    unsigned sum, cnt, mine, sp = 0u;
    for (;;) {
        sum = 0u; cnt = 0u; mine = 0u;
#pragma unroll
        for (unsigned j = 0; j < 16; ++j) { const unsigned c = xb_ld(&bar[XB_XCNT(j)]); sum += c; cnt += (c > 0u) ? 1u : 0u; mine = (j == x) ? c : mine; }
        if (sum == G) break;
        __builtin_amdgcn_s_sleep(1);
        if ((++sp & 255u) == 0u) { if (xb_ld(&bar[XB_TMO])) break; if (sp > XB_SPIN_CAP) { atomicAdd(&bar[XB_TMO], 1u); break; } }
    }
    nloc = mine > 0u ? mine : 1u; nx = cnt > 0u ? cnt : 1u;
}
__device__ __forceinline__ void xcd_barrier(const XcdBarrier& b) {
    asm volatile("s_waitcnt vmcnt(0)" ::: "memory");
    __syncthreads();
    if (threadIdx.x == 0) {
        unsigned* bar = b.bar;
        __builtin_amdgcn_s_waitcnt(0);
        unsigned nloc = b.st[0], nx = b.st[1];
        if (nloc == 0u) { xcd_barrier_complete(bar, b.x, nloc, nx); b.st[0] = nloc; b.st[1] = nx; }
        const unsigned old = xb_add(&bar[XB_XSUB(b.x)], 1u);
        const unsigned gen = old / nloc;
        if (old + 1u == (gen + 1u) * nloc) {
            __builtin_amdgcn_fence(__ATOMIC_RELEASE, "agent");
            asm volatile("s_waitcnt vmcnt(0)" ::: "memory");
            const unsigned og = xb_add(&bar[XB_TOP], 1u);
            const unsigned tg = og / nx;
            if (og + 1u == (tg + 1u) * nx) xb_add(&bar[XB_TOPGEN], 1u);
            else XB_SPIN(xb_ld(&bar[XB_TOPGEN]) == tg, bar);
            __builtin_amdgcn_fence(__ATOMIC_ACQUIRE, "agent");
            xb_add(&bar[XB_XGEN(b.x)], 1u);
            asm volatile("s_waitcnt vmcnt(0)" ::: "memory");
        } else {
            XB_SPIN(xb_ld(&bar[XB_XGEN(b.x)]) == gen, bar);
            __builtin_amdgcn_fence(__ATOMIC_ACQUIRE, "agent");
            asm volatile("s_waitcnt vmcnt(0)" ::: "memory");
        }
    }
    __syncthreads();
}

struct Params {
  const float *x, *attn_norm_w, *w_in, *q_norm_w, *k_norm_w, *lq1, *lk1, *lq2, *lk2, *subln_w, *gate_up_w, *gate_up_b, *gla_norm_w,
              *w_out, *ffn_norm_w, *router_w, *router_b, *wg, *bg, *wu, *bu, *wd, *bd;
  float* out;
  unsigned* bar; unsigned* cnt;
  bf16_t *wt_in, *wt_out, *wgd_hi, *wgd_lo, *hn, *proj, *mix, *qtil, *st, *tb, *wr_hi, *wr_lo, *act, *y;
  float *gd, *decay, *pw; bf16_t *oib, *Ub;
  int* list;
};

constexpr int BM = 256, BK = 64, HALF = 128, HTB = HALF * BK * 2, KDIM = 2048, NKT = KDIM / BK;
__device__ __forceinline__ int lds_byte(int r, int c) { const int st = (r >> 4) * 2 + (c >> 5), rr = r & 15, cc = c & 31, ob = rr * 64 + cc * 2; return st * 1024 + (ob ^ (((ob >> 9) & 1) << 5)); }
__device__ __forceinline__ void stage_rc(int b, int& R, int& C) { const int st = b / 1024, sb = b % 1024, swz = sb ^ (((sb >> 9) & 1) << 5); R = (st >> 1) * 16 + swz / 64; C = (st & 1) * 32 + (swz % 64) / 2; }
__device__ __forceinline__ int perm32(int rho) { const int n = rho >> 4, i = rho & 15; return 8 * (i >> 2) + 4 * n + (i & 3); }

typedef __amdgpu_buffer_rsrc_t rsrc_t;
__device__ __forceinline__ rsrc_t mk_rsrc(const void* p) { return __builtin_amdgcn_make_buffer_rsrc((void*)p, 0, 0x7fffffff, 0x00020000); }
__device__ __forceinline__ void bglds16(rsrc_t r, unsigned voff, unsigned soff, LAS char* l) { __builtin_amdgcn_raw_ptr_buffer_load_lds(r, (LAS unsigned*)l, 16, (int)voff, (int)soff, 0, 0); }

template <class Epi>
__device__ __forceinline__ void gemm_unit(LAS char* lds, const rsrc_t RA, const unsigned (&ao)[2][2], const rsrc_t RB0, const rsrc_t RB1, const unsigned (&bo)[2], const Epi& E,
                                          const int pre = 0, const int nx = 0, const rsrc_t RB0n = rsrc_t(), const rsrc_t RB1n = rsrc_t(), const unsigned (&bon)[2] = {0u, 0u}) {
  const int tid = otid(), wid = __builtin_amdgcn_readfirstlane(tid >> 6), lane = tid & 63, wr = wid >> 2, wc = wid & 3, fr = lane & 15, fq = lane >> 4;
  const unsigned ldsw = (unsigned)wid * 1024u;
  const int aoff = lds_byte(wr * 64 + fr, fq * 8), boff = lds_byte(wc * 32 + fr, fq * 8);
#define G_SA(b, h) (((b) * 2 + (h)) * HTB)
#define G_SB(b, h) ((4 + (b) * 2 + (h)) * HTB)
#define G_STAGE_A(b, h, kt) do { const unsigned _so = (unsigned)(kt) * (BK * 2); bglds16(RA, ao[h][0], _so, lds + G_SA(b, h) + ldsw); bglds16(RA, ao[h][1], _so, lds + G_SA(b, h) + ldsw + 8192); } while (0)
#define G_STAGE_B(b, h, kt) do { const unsigned _so = (unsigned)(kt) * (BK * 2); bglds16((h) ? RB1 : RB0, bo[0], _so, lds + G_SB(b, h) + ldsw); bglds16((h) ? RB1 : RB0, bo[1], _so, lds + G_SB(b, h) + ldsw + 8192); } while (0)
#define G_LDA(dst, b, h) do { _Pragma("unroll") for (int m = 0; m < 4; ++m) _Pragma("unroll") for (int k = 0; k < 2; ++k) dst[m][k] = *(const LAS bf16x8*)(lds + G_SA(b, h) + aoff + m * 2048 + k * 1024); } while (0)
#define G_LDB(dst, b, h) do { _Pragma("unroll") for (int n = 0; n < 2; ++n) _Pragma("unroll") for (int k = 0; k < 2; ++k) dst[n][k] = *(const LAS bf16x8*)(lds + G_SB(b, h) + boff + n * 2048 + k * 1024); } while (0)
#define G_MMA(ai, bj, At, Bt) do { __builtin_amdgcn_s_setprio(1); _Pragma("unroll") for (int m = 0; m < 4; ++m) _Pragma("unroll") for (int n = 0; n < 2; ++n) _Pragma("unroll") for (int k = 0; k < 2; ++k) \
    acc[ai][bj][m][n] = __builtin_amdgcn_mfma_f32_16x16x32_bf16(Bt[n][k], At[m][k], acc[ai][bj][m][n], 0, 0, 0); __builtin_amdgcn_s_setprio(0); } while (0)
#define G_WV(n) asm volatile("s_waitcnt vmcnt(" #n ")" ::: "memory")
#define G_WL(n) asm volatile("s_waitcnt lgkmcnt(" #n ")" ::: "memory")
#define G_BAR __builtin_amdgcn_s_barrier()
#define G_SCHED __builtin_amdgcn_sched_barrier(0)
  f32x4 acc[2][2][4][2];
#pragma unroll
  for (int a = 0; a < 2; ++a)
#pragma unroll
    for (int b = 0; b < 2; ++b)
#pragma unroll
      for (int m = 0; m < 4; ++m)
#pragma unroll
        for (int n = 0; n < 2; ++n) acc[a][b][m][n] = (f32x4){0.f, 0.f, 0.f, 0.f};
  bf16x8 At[4][2], Bq0[2][2], Bq1[2][2];
  if (!pre) { G_STAGE_B(0, 0, 0); G_STAGE_A(0, 0, 0); G_STAGE_B(0, 1, 0); G_STAGE_A(0, 1, 0); }
  if (wr == 1) G_BAR;
  G_WV(4); G_BAR;
  G_STAGE_B(1, 0, 1); G_STAGE_A(1, 0, 1); G_STAGE_B(1, 1, 1);
  G_WV(6); G_BAR;
  for (int t = 0; t < NKT - 2; t += 2) {
    G_LDB(Bq0, 0, 0); G_SCHED; G_LDA(At, 0, 0); G_STAGE_A(1, 1, t + 1);
    G_WL(8); G_BAR; G_WL(0); G_MMA(0, 0, At, Bq0); G_BAR; G_SCHED;
    G_LDB(Bq1, 0, 1); G_STAGE_B(0, 0, t + 2);
    G_BAR; G_WL(0); G_MMA(0, 1, At, Bq1); G_BAR;
    G_LDA(At, 0, 1); G_STAGE_A(0, 0, t + 2);
    G_BAR; G_WL(0); G_MMA(1, 0, At, Bq0); G_BAR; G_SCHED;
    G_STAGE_B(0, 1, t + 2);
    G_WV(6); G_BAR; G_MMA(1, 1, At, Bq1); G_BAR;
    G_LDB(Bq0, 1, 0); G_SCHED; G_LDA(At, 1, 0); G_STAGE_A(0, 1, t + 2);
    G_WL(8); G_BAR; G_WL(0); G_MMA(0, 0, At, Bq0); G_BAR; G_SCHED;
    G_LDB(Bq1, 1, 1); G_STAGE_B(1, 0, t + 3);
    G_BAR; G_WL(0); G_MMA(0, 1, At, Bq1); G_BAR;
    G_LDA(At, 1, 1); G_STAGE_A(1, 0, t + 3);
    G_BAR; G_WL(0); G_MMA(1, 0, At, Bq0); G_BAR; G_SCHED;
    G_STAGE_B(1, 1, t + 3);
    G_WV(6); G_BAR; G_MMA(1, 1, At, Bq1); G_BAR;
  }
  { G_LDB(Bq0, 0, 0); G_LDA(At, 0, 0); G_STAGE_A(1, 1, NKT - 1);
    G_BAR; G_WL(0); G_MMA(0, 0, At, Bq0); G_BAR;
    G_LDB(Bq1, 0, 1); G_BAR; G_WL(0); G_MMA(0, 1, At, Bq1); G_BAR;
    G_LDA(At, 0, 1); G_WV(4); G_BAR; G_WL(0); G_MMA(1, 0, At, Bq0); G_MMA(1, 1, At, Bq1); G_BAR; }
  { G_LDB(Bq0, 1, 0); G_LDA(At, 1, 0); G_WV(2); G_BAR; G_WL(0); G_MMA(0, 0, At, Bq0); G_BAR;
    G_LDB(Bq1, 1, 1); G_WV(0); G_BAR; G_WL(0); G_MMA(0, 1, At, Bq1); G_BAR;
    G_LDA(At, 1, 1); G_BAR; G_WL(0); G_MMA(1, 0, At, Bq0); G_MMA(1, 1, At, Bq1); G_BAR; }
  if (wr == 0) G_BAR;
  if (nx) {
    bglds16(RB0n, bon[0], 0u, lds + G_SB(0, 0) + ldsw); bglds16(RB0n, bon[1], 0u, lds + G_SB(0, 0) + ldsw + 8192); G_STAGE_A(0, 0, 0);
    bglds16(RB1n, bon[0], 0u, lds + G_SB(0, 1) + ldsw); bglds16(RB1n, bon[1], 0u, lds + G_SB(0, 1) + ldsw + 8192); G_STAGE_A(0, 1, 0); }
  { int tz = otid(); asm volatile("" : "+v"(tz)); const int wid2 = tz >> 6, lane2 = tz & 63; E(acc, wid2 >> 2, wid2 & 3, lane2 & 15, lane2 >> 4); }
#undef G_SA
#undef G_SB
#undef G_STAGE_A
#undef G_STAGE_B
#undef G_LDA
#undef G_LDB
#undef G_MMA
#undef G_WV
#undef G_WL
#undef G_BAR
#undef G_SCHED
}


__device__ __forceinline__ u32x4 bl_asm0(unsigned voff, rsrc_t r, unsigned soff) { u32x4 x; asm volatile("s_nop 4\n\tbuffer_load_dwordx4 %0, %1, %2, %3 offen" : "=v"(x) : "v"(voff), "s"(r), "s"(soff) : "memory"); return x; }
__device__ __forceinline__ u32x4 bl_asm1(unsigned voff, rsrc_t r, unsigned soff) { u32x4 x; asm volatile("buffer_load_dwordx4 %0, %1, %2, %3 offen" : "=v"(x) : "v"(voff), "s"(r), "s"(soff) : "memory"); return x; }
template <int OFF> __device__ __forceinline__ s16x4 trb(int vb) { s16x4 r; asm volatile("ds_read_b64_tr_b16 %0, %1 offset:%2" : "=v"(r) : "v"(vb), "i"(OFF) : "memory"); return r; }
template <bool HALF, class Epi>
__device__ __forceinline__ void gemm_unit_f32b(LAS char* lds, const rsrc_t RA, const unsigned (&ao)[2][2], const rsrc_t RB0, const rsrc_t RB1, const Epi& E) {
  const int tid = otid(), wid = __builtin_amdgcn_readfirstlane(tid >> 6), lane = tid & 63, wr = wid >> 2, wc = wid & 3, fr = lane & 15, fq = lane >> 4;
  const unsigned ldsw = (unsigned)wid * 1024u;
  const int aoff = lds_byte(wr * 64 + fr, fq * 8);
  constexpr int BREG = 65536;
  const int ldsb = (int)(unsigned)(uintptr_t)lds;
  const int q4 = fr >> 2, pp = lane & 3, frd = q4 | ((fq & 1) << 2);
  const int kb = ldsb + BREG + (8 * fq + q4) * 512 + pp * 8;
  const int brd0 = kb + (((2 * wc + 0) ^ frd) << 5), brd1 = kb + (((2 * wc + 1) ^ frd) << 5);
  const int n4 = lane & 31, hiw = lane >> 5, fwx = hiw | ((wid & 1) << 2), fwy = fwx ^ 2;
  LAS char* bwx = lds + BREG + (8 * wid + hiw) * 512 + (((n4 >> 2) ^ fwx) << 5) + (n4 & 3) * 8;
  LAS char* bwy = lds + BREG + (8 * wid + hiw + 2) * 512 + (((n4 >> 2) ^ fwy) << 5) + (n4 & 3) * 8;
  const unsigned bvoff = (unsigned)(hiw * 8192 + n4 * 16);
  const unsigned bsw = (unsigned)wid * 65536u;
#define F_SA(b, h) (((b) * 2 + (h)) * HTB)
#define F_STAGE_A(b, h, kt) do { const unsigned _so = (unsigned)(kt) * (BK * 2); bglds16(RA, ao[h][0], _so, lds + F_SA(b, h) + ldsw); bglds16(RA, ao[h][1], _so, lds + F_SA(b, h) + ldsw + 8192); } while (0)
#define F_LDA(dst, b, h) do { _Pragma("unroll") for (int m = 0; m < 4; ++m) _Pragma("unroll") for (int k = 0; k < 2; ++k) dst[m][k] = *(const LAS bf16x8*)(lds + F_SA(b, h) + aoff + m * 2048 + k * 1024); } while (0)
#define F_TR1(dst, base, b, ks, bj) do { const s16x4 _l = trb<(b) * 32768 + (ks) * 16384 + (bj) * 256>(base), _h = trb<(b) * 32768 + (ks) * 16384 + 2048 + (bj) * 256>(base); \
    dst = (bf16x8){_l[0], _l[1], _l[2], _l[3], _h[0], _h[1], _h[2], _h[3]}; } while (0)
#define F_LDB(dst, b, bj) do { F_TR1(dst[0][0], brd0, b, 0, bj); F_TR1(dst[0][1], brd0, b, 1, bj); F_TR1(dst[1][0], brd1, b, 0, bj); F_TR1(dst[1][1], brd1, b, 1, bj); } while (0)
#define F_MMA(ai, bj, At, Bt) do { __builtin_amdgcn_s_setprio(1); _Pragma("unroll") for (int m = 0; m < 4; ++m) _Pragma("unroll") for (int n = 0; n < 2; ++n) _Pragma("unroll") for (int k = 0; k < 2; ++k) \
    acc[ai][bj][m][n] = __builtin_amdgcn_mfma_f32_16x16x32_bf16(Bt[n][k], At[m][k], acc[ai][bj][m][n], 0, 0, 0); __builtin_amdgcn_s_setprio(0); } while (0)
#define F_BLOAD(SX, SY, kt, i) do { const unsigned _so = (unsigned)(kt) * 524288u + bsw + (unsigned)((i) >> 1) * 32768u; \
    const unsigned _so2 = _so + 16384u; if ((i) & 1) { SX = bl_asm1(bvoff, RB1, _so); SY = bl_asm1(bvoff, RB1, _so2); } else { SX = bl_asm1(bvoff, RB0, _so); SY = bl_asm1(bvoff, RB0, _so2); } } while (0)
#define F_BLOAD_FIRST(SX, SY) do { SX = bl_asm0(bvoff, RB0, bsw); SY = bl_asm1(bvoff, RB0, bsw + 16384u); } while (0)
#define F_BWAIT(SX, SY, n) asm volatile("s_waitcnt vmcnt(" #n ")" : "+v"(SX), "+v"(SY) :: "memory")
#define F_BWRITE(SX, SY, b, i) do { u32x2 _wx, _wy; _wx.x = cvt_pk_bf16(__uint_as_float(SX.x), __uint_as_float(SX.y)); _wx.y = cvt_pk_bf16(__uint_as_float(SX.z), __uint_as_float(SX.w)); \
    _wy.x = cvt_pk_bf16(__uint_as_float(SY.x), __uint_as_float(SY.y)); _wy.y = cvt_pk_bf16(__uint_as_float(SY.z), __uint_as_float(SY.w)); \
    *(LAS u32x2*)(bwx + (b) * 32768 + ((i) >> 1) * 2048 + ((i) & 1) * 256) = _wx; *(LAS u32x2*)(bwy + (b) * 32768 + ((i) >> 1) * 2048 + ((i) & 1) * 256) = _wy; } while (0)
#define F_BWAITH(SX, SY, nfull, nhalf) do { if constexpr (HALF) { F_BWAIT(SX, SY, nhalf); } else { F_BWAIT(SX, SY, nfull); } } while (0)
#define F_WL(n) asm volatile("s_waitcnt lgkmcnt(" #n ")" ::: "memory")
#define F_BAR __builtin_amdgcn_s_barrier()
#define F_SCHED __builtin_amdgcn_sched_barrier(0)
  f32x4 acc[2][2][4][2];
  E.init(acc, wc, fq);
  bf16x8 At[4][2], Bq0[2][2], Bq1[2][2];
  u32x4 Ex, Ey, Ox, Oy;
  F_STAGE_A(0, 0, 0); if constexpr (!HALF) F_STAGE_A(0, 1, 0); F_STAGE_A(1, 0, 1);
  { u32x4 P0x, P0y, P1x, P1y, P2x, P2y, P3x, P3y, P4x, P4y;
    F_BLOAD_FIRST(P0x, P0y); F_BLOAD(P1x, P1y, 0, 1); F_BLOAD(P2x, P2y, 0, 2); F_BLOAD(P3x, P3y, 0, 3); F_BLOAD(P4x, P4y, 1, 0);
    F_BLOAD(Ox, Oy, 1, 1); F_BLOAD(Ex, Ey, 1, 2);
    F_BWAIT(P0x, P0y, 12); F_BWRITE(P0x, P0y, 0, 0);
    F_BWAIT(P1x, P1y, 10); F_BWRITE(P1x, P1y, 0, 1);
    F_BWAIT(P2x, P2y, 8); F_BWRITE(P2x, P2y, 0, 2);
    F_BWAIT(P3x, P3y, 6); F_BWRITE(P3x, P3y, 0, 3);
    F_BWAIT(P4x, P4y, 4); F_BWRITE(P4x, P4y, 1, 0); }
  F_WL(0);
  if (wr == 1) F_BAR;
  F_BAR;
  for (int t = 0; t < NKT - 2; t += 2) {
    const int t2 = t + 2, t3 = t + 3;
    F_LDB(Bq0, 0, 0); F_LDA(At, 0, 0); if constexpr (!HALF) F_STAGE_A(1, 1, t + 1);
    F_BWAITH(Ox, Oy, 4, 2); F_BWRITE(Ox, Oy, 1, 1); F_BLOAD(Ox, Oy, t + 1, 3);
    F_BAR; F_WL(0); F_SCHED; F_MMA(0, 0, At, Bq0); F_BAR; F_SCHED;
    F_LDB(Bq1, 0, 1);
    F_BWAITH(Ex, Ey, 4, 2); F_BWRITE(Ex, Ey, 1, 2); F_BLOAD(Ex, Ey, t2, 0);
    F_BAR; F_WL(0); F_SCHED; F_MMA(0, 1, At, Bq1); F_BAR; F_SCHED;
    if constexpr (!HALF) F_LDA(At, 0, 1); F_STAGE_A(0, 0, t2);
    F_BWAIT(Ox, Oy, 4); F_BWRITE(Ox, Oy, 1, 3); F_BLOAD(Ox, Oy, t2, 1);
    F_BAR; F_WL(0); F_SCHED; if constexpr (!HALF) F_MMA(1, 0, At, Bq0); F_BAR; F_SCHED;
    F_BWAIT(Ex, Ey, 4); F_BWRITE(Ex, Ey, 0, 0); F_BLOAD(Ex, Ey, t2, 2);
    F_BAR; F_WL(0); F_SCHED; if constexpr (!HALF) F_MMA(1, 1, At, Bq1); F_BAR; F_SCHED;
    F_LDB(Bq0, 1, 0); F_LDA(At, 1, 0); if constexpr (!HALF) F_STAGE_A(0, 1, t2);
    F_BWAITH(Ox, Oy, 4, 2); F_BWRITE(Ox, Oy, 0, 1); F_BLOAD(Ox, Oy, t2, 3);
    F_BAR; F_WL(0); F_SCHED; F_MMA(0, 0, At, Bq0); F_BAR; F_SCHED;
    F_LDB(Bq1, 1, 1);
    F_BWAITH(Ex, Ey, 4, 2); F_BWRITE(Ex, Ey, 0, 2); F_BLOAD(Ex, Ey, t3, 0);
    F_BAR; F_WL(0); F_SCHED; F_MMA(0, 1, At, Bq1); F_BAR; F_SCHED;
    if constexpr (!HALF) F_LDA(At, 1, 1); F_STAGE_A(1, 0, t3);
    F_BWAIT(Ox, Oy, 4); F_BWRITE(Ox, Oy, 0, 3); F_BLOAD(Ox, Oy, t3, 1);
    F_BAR; F_WL(0); F_SCHED; if constexpr (!HALF) F_MMA(1, 0, At, Bq0); F_BAR; F_SCHED;
    F_BWAIT(Ex, Ey, 4); F_BWRITE(Ex, Ey, 1, 0); F_BLOAD(Ex, Ey, t3, 2);
    F_BAR; F_WL(0); F_SCHED; if constexpr (!HALF) F_MMA(1, 1, At, Bq1); F_BAR; F_SCHED;
  }
  {
    F_LDB(Bq0, 0, 0); F_LDA(At, 0, 0); if constexpr (!HALF) F_STAGE_A(1, 1, NKT - 1);
    F_BWAITH(Ox, Oy, 4, 2); F_BWRITE(Ox, Oy, 1, 1); F_BLOAD(Ox, Oy, NKT - 1, 3);
    F_BAR; F_WL(0); F_SCHED; F_MMA(0, 0, At, Bq0); F_BAR; F_SCHED;
    F_LDB(Bq1, 0, 1);
    F_BWAITH(Ex, Ey, 4, 2); F_BWRITE(Ex, Ey, 1, 2);
    F_BAR; F_WL(0); F_SCHED; F_MMA(0, 1, At, Bq1); F_BAR; F_SCHED;
    if constexpr (!HALF) F_LDA(At, 0, 1);
    F_BWAIT(Ox, Oy, 0); F_BWRITE(Ox, Oy, 1, 3);
    F_BAR; F_WL(0); F_SCHED; if constexpr (!HALF) F_MMA(1, 0, At, Bq0); F_BAR; F_SCHED;
    F_BAR; F_SCHED; if constexpr (!HALF) F_MMA(1, 1, At, Bq1); F_BAR; F_SCHED;
    F_LDB(Bq0, 1, 0); F_LDA(At, 1, 0);
    F_BAR; F_WL(0); F_SCHED; F_MMA(0, 0, At, Bq0); F_BAR; F_SCHED;
    F_LDB(Bq1, 1, 1);
    F_BAR; F_WL(0); F_SCHED; F_MMA(0, 1, At, Bq1); F_BAR; F_SCHED;
    if constexpr (!HALF) F_LDA(At, 1, 1);
    E.template part<0, 0, 2>(acc, wr, wc, fr, fq);
    F_BAR; F_WL(0); F_SCHED; if constexpr (!HALF) F_MMA(1, 0, At, Bq0); F_BAR; F_SCHED;
    E.template part<0, 2, 4>(acc, wr, wc, fr, fq);
    F_BAR; F_SCHED; if constexpr (!HALF) F_MMA(1, 1, At, Bq1); F_BAR; F_SCHED;
  }
  if (wr == 0) F_BAR;
  if constexpr (!HALF) { int tz = threadIdx.x; asm volatile("" : "+v"(tz)); const int wid2 = tz >> 6, lane2 = tz & 63; E.template part<1, 0, 4>(acc, wid2 >> 2, wid2 & 3, lane2 & 15, lane2 >> 4); }
#undef F_SA
#undef F_STAGE_A
#undef F_LDA
#undef F_TR1
#undef F_LDB
#undef F_MMA
#undef F_BLOAD
#undef F_BLOAD_FIRST
#undef F_BWAIT
#undef F_BWAITH
#undef F_BWRITE
#undef F_WL
#undef F_BAR
#undef F_SCHED
}

template <bool PERM> __device__ __forceinline__ void b_offsets(unsigned (&bo)[2]) {
#pragma unroll
  for (int i = 0; i < 2; ++i) { int R, C; stage_rc(otid() * 16 + i * 8192, R, C); const int Rb = PERM ? ((R & ~31) + perm32(R & 31)) : R; bo[i] = (unsigned)(Rb * KDIM + C) * 2u; }
}

__device__ __forceinline__ void ph_norm_gd(const Params& p, LAS char* lds) {
  const int tid = otid(), wid = tid >> 6, lane = tid & 63;
  f32x4 nw[8];
#pragma unroll
  for (int i = 0; i < 8; ++i) nw[i] = *(const f32x4*)(p.attn_norm_w + (i >> 1) * 512 + lane * 8 + (i & 1) * 4);
  for (int row = (blockIdx.x * 8 + wid) * 2; row < T_TOK; row += gridDim.x * 16) {
    const float* xr = p.x + (size_t)row * DM;
    f32x4 v[8], w2[8]; float ss = 0.f, s2 = 0.f;
#pragma unroll
    for (int i = 0; i < 8; ++i) { const int co = (i >> 1) * 512 + lane * 8 + (i & 1) * 4; v[i] = *(const f32x4*)(xr + co); w2[i] = *(const f32x4*)(xr + DM + co); }
#pragma unroll
    for (int i = 0; i < 8; ++i) { ss += v[i][0] * v[i][0] + v[i][1] * v[i][1] + v[i][2] * v[i][2] + v[i][3] * v[i][3]; s2 += w2[i][0] * w2[i][0] + w2[i][1] * w2[i][1] + w2[i][2] * w2[i][2] + w2[i][3] * w2[i][3]; }
    ss = wave_sum(ss); s2 = wave_sum(s2);
    const float rstd = rsqrtf(ss * (1.0f / 2048.0f) + 1e-6f), rstd2 = rsqrtf(s2 * (1.0f / 2048.0f) + 1e-6f);
#pragma unroll
    for (int i = 0; i < 4; ++i) { const f32x4 a0 = v[2 * i] * rstd * nw[2 * i], a1 = v[2 * i + 1] * rstd * nw[2 * i + 1], b0 = w2[2 * i] * rstd2 * nw[2 * i], b1 = w2[2 * i + 1] * rstd2 * nw[2 * i + 1];
      u32x4 o; o.x = cvt_pk_bf16(a0[0], a0[1]); o.y = cvt_pk_bf16(a0[2], a0[3]); o.z = cvt_pk_bf16(a1[0], a1[1]); o.w = cvt_pk_bf16(a1[2], a1[3]); *(u32x4*)(p.hn + (size_t)row * DM + i * 512 + lane * 8) = o;
      u32x4 o2; o2.x = cvt_pk_bf16(b0[0], b0[1]); o2.y = cvt_pk_bf16(b0[2], b0[3]); o2.z = cvt_pk_bf16(b1[0], b1[1]); o2.w = cvt_pk_bf16(b1[2], b1[3]); *(u32x4*)(p.hn + (size_t)(row + 1) * DM + i * 512 + lane * 8) = o2; }
  }
}
__device__ __forceinline__ void ph_gdown(const Params& p, LAS char* lds) {
  const int tid = otid(), wid = tid >> 6, lane = tid & 63, fr = lane & 15, fq = lane >> 4, rt = wid >> 2, kq = wid & 3;
  LAS float* part = (LAS float*)lds;
  for (int task = blockIdx.x; task < T_TOK / 32; task += gridDim.x) {
    const int row = task * 32 + rt * 16 + fr;
    const bf16_t* ar = p.hn + (size_t)row * DM + kq * 512 + fq * 8;
    const bf16_t* wh = p.wgd_hi + fr * 2048 + kq * 512 + fq * 8; const bf16_t* wl = p.wgd_lo + fr * 2048 + kq * 512 + fq * 8;
    f32x4 acc = {0.f, 0.f, 0.f, 0.f};
#pragma unroll 8
    for (int ks = 0; ks < 16; ++ks) { const bf16x8 a = *(const bf16x8*)(ar + ks * 32), bh = *(const bf16x8*)(wh + ks * 32), bl = *(const bf16x8*)(wl + ks * 32);
      acc = __builtin_amdgcn_mfma_f32_16x16x32_bf16(a, bh, acc, 0, 0, 0); acc = __builtin_amdgcn_mfma_f32_16x16x32_bf16(a, bl, acc, 0, 0, 0); }
    LAS float* pw_ = part + (rt * 4 + kq) * (16 * 17);
#pragma unroll
    for (int r = 0; r < 4; ++r) pw_[(fq * 4 + r) * 17 + fr] = acc[r];
    __syncthreads();
    if (tid < 512) { const int rr = tid >> 4, cc = tid & 15, rt2 = rr >> 4, r16 = rr & 15; const LAS float* q_ = part + (rt2 * 4) * (16 * 17) + r16 * 17 + cc;
      p.gd[(size_t)(task * 32 + rr) * 16 + cc] = q_[0] + q_[16 * 17] + q_[2 * 16 * 17] + q_[3 * 16 * 17]; }
    __syncthreads();
  }
}

__device__ __forceinline__ void ph_convert(const Params& p, LAS char* lds) {
  const int tid = otid();
  LAS float* tile = (LAS float*)lds;
  constexpr int NT_TOTAL = 1536 + 512;
  auto tile_src = [&](int tI, const float*& src, bf16_t*& dst, int& ld, int& k0, int& n0) { int ntn, local;
    if (tI < 1536) { src = p.w_in; dst = p.wt_in; ld = LDW; ntn = 48; local = tI; } else { src = p.w_out; dst = p.wt_out; ld = 2048; ntn = 16; local = tI - 1536; }
    const int tn = local % ntn, tk = local / ntn; k0 = tk * 64; n0 = tn * 128; };
  const int lr = tid >> 5, lc4 = (tid & 31) * 4;
  f32x4 pv[4];
  { const int tI = blockIdx.x; if (tI < NT_TOTAL) { const float* src; bf16_t* dst; int ld, k0, n0; tile_src(tI, src, dst, ld, k0, n0);
#pragma unroll
      for (int ps = 0; ps < 4; ++ps) pv[ps] = *(const f32x4*)(src + (size_t)(k0 + ps * 16 + lr) * ld + n0 + lc4); } }
  for (int tI = blockIdx.x; tI < NT_TOTAL; tI += gridDim.x) {
    const float* src; bf16_t* dst; int ld, k0, n0; tile_src(tI, src, dst, ld, k0, n0);
#pragma unroll
    for (int ps = 0; ps < 4; ++ps) *(LAS f32x4*)(tile + (ps * 16 + lr) * 132 + lc4) = pv[ps];
    __syncthreads();
    { const int tN = tI + gridDim.x; if (tN < NT_TOTAL) { const float* s2; bf16_t* d2; int ld2, k2, n2; tile_src(tN, s2, d2, ld2, k2, n2);
#pragma unroll
        for (int ps = 0; ps < 4; ++ps) pv[ps] = *(const f32x4*)(s2 + (size_t)(k2 + ps * 16 + lr) * ld2 + n2 + lc4); } }
    { const int n = tid >> 2, kq = (tid & 3) * 16; float f[16];
#pragma unroll
      for (int j = 0; j < 16; ++j) f[j] = tile[(kq + j) * 132 + n];
      u32x4 a, b; a.x = cvt_pk_bf16(f[0], f[1]); a.y = cvt_pk_bf16(f[2], f[3]); a.z = cvt_pk_bf16(f[4], f[5]); a.w = cvt_pk_bf16(f[6], f[7]);
      b.x = cvt_pk_bf16(f[8], f[9]); b.y = cvt_pk_bf16(f[10], f[11]); b.z = cvt_pk_bf16(f[12], f[13]); b.w = cvt_pk_bf16(f[14], f[15]);
      bf16_t* o = dst + (size_t)(n0 + n) * 2048 + k0 + kq; *(u32x4*)o = a; *(u32x4*)(o + 8) = b; }
    __syncthreads();
  }
  for (int i = blockIdx.x * 512 + tid; i < 2048 * 32; i += gridDim.x * 512) { const int d = i >> 5, e = i & 31; const float w = p.router_w[i];
    const bf16_t h = f2bf(w); const bf16_t l = f2bf(w - bf2f(h)); p.wr_hi[e * 2048 + d] = h; p.wr_lo[e * 2048 + d] = l; }
  for (int i = blockIdx.x * 512 + tid; i < 2048 * 16; i += gridDim.x * 512) { const int d = i >> 4, c = i & 15; const float w = p.w_in[(size_t)d * LDW + 6144 + c];
    const bf16_t h = f2bf(w); const bf16_t l = f2bf(w - bf2f(h)); p.wgd_hi[c * 2048 + d] = h; p.wgd_lo[c * 2048 + d] = l; }
}

struct EpiProj { bf16_t* O; int pm, pn, ld;
  __device__ __forceinline__ void operator()(const f32x4 (&acc)[2][2][4][2], int wr, int wc, int fr, int fq) const {
#pragma unroll
    for (int ai = 0; ai < 2; ++ai)
#pragma unroll
      for (int m = 0; m < 4; ++m) { bf16_t* rowp = O + (size_t)(pm * 256 + ai * 128 + wr * 64 + m * 16 + fr) * ld + pn * 256 + wc * 32 + 8 * fq;
#pragma unroll
        for (int bj = 0; bj < 2; ++bj) { const f32x4 v0 = acc[ai][bj][m][0], v1 = acc[ai][bj][m][1]; u32x4 w; w.x = cvt_pk_bf16(v0[0], v0[1]); w.y = cvt_pk_bf16(v0[2], v0[3]); w.z = cvt_pk_bf16(v1[0], v1[1]); w.w = cvt_pk_bf16(v1[2], v1[3]);
          *(u32x4*)(rowp + bj * 128) = w; } }
  } };
struct EpiProjK { bf16_t* O; const float* kw; int pm, pn;
  __device__ __forceinline__ void operator()(const f32x4 (&acc)[2][2][4][2], int wr, int wc, int fr, int fq) const {
    f32x4 w4[2][2];
#pragma unroll
    for (int bj = 0; bj < 2; ++bj) { w4[bj][0] = *(const f32x4*)(kw + bj * 32 + 8 * fq); w4[bj][1] = *(const f32x4*)(kw + bj * 32 + 8 * fq + 4); }
#pragma unroll
    for (int ai = 0; ai < 2; ++ai)
#pragma unroll
      for (int m = 0; m < 4; ++m) { bf16_t* rowp = O + (size_t)(pm * 256 + ai * 128 + wr * 64 + m * 16 + fr) * NP + pn * 256 + wc * 64 + 8 * fq;
        float ss = 0.f;
#pragma unroll
        for (int bj = 0; bj < 2; ++bj)
#pragma unroll
          for (int n = 0; n < 2; ++n) { const f32x4 v = acc[ai][bj][m][n]; ss += v[0] * v[0] + v[1] * v[1] + v[2] * v[2] + v[3] * v[3]; }
        ss += __shfl_xor(ss, 16); ss += __shfl_xor(ss, 32);
        const float rstd = rsqrtf(ss * (1.0f / 64.0f) + 1e-6f);
#pragma unroll
        for (int bj = 0; bj < 2; ++bj) { const f32x4 v0 = acc[ai][bj][m][0] * rstd * w4[bj][0], v1 = acc[ai][bj][m][1] * rstd * w4[bj][1];
          u32x4 w; w.x = cvt_pk_bf16(v0[0], v0[1]); w.y = cvt_pk_bf16(v0[2], v0[3]); w.z = cvt_pk_bf16(v1[0], v1[1]); w.w = cvt_pk_bf16(v1[2], v1[3]);
          *(u32x4*)(rowp + bj * 32) = w; } }
  } };
__device__ __forceinline__ void ph_inproj(const Params& p, LAS char* lds) {
  unsigned bo[2]; b_offsets<true>(bo);
  unsigned boK[2];
#pragma unroll
  for (int i = 0; i < 2; ++i) { int R, C; stage_rc(otid() * 16 + i * 8192, R, C); boK[i] = (unsigned)(((R >> 5) * 64 + perm32(R & 31)) * KDIM + C) * 2u; }
  int pre = 0;
  for (int u = blockIdx.x; u < 32 * 24; u += gridDim.x) {
    const int pm = u & 31, pn = u >> 5;
    unsigned ao[2][2];
#pragma unroll
    for (int h = 0; h < 2; ++h)
#pragma unroll
      for (int i = 0; i < 2; ++i) { int R, C; stage_rc(otid() * 16 + i * 8192, R, C); ao[h][i] = (unsigned)((pm * 256 + h * 128 + R) * KDIM + C) * 2u; }
    const int un = u + gridDim.x, pnn = un >> 5, nx = (un < 32 * 24 && (un & 31) == pm) ? 1 : 0, kn = (pnn >= 4 && pnn < 8) ? 1 : 0;
    const rsrc_t RB0n = mk_rsrc(p.wt_in + (size_t)(pnn * 256) * KDIM), RB1n = mk_rsrc(p.wt_in + (size_t)(pnn * 256 + (kn ? 32 : 128)) * KDIM);
    unsigned bon[2]; bon[0] = kn ? boK[0] : bo[0]; bon[1] = kn ? boK[1] : bo[1];
    if (pn >= 4 && pn < 8) { EpiProjK E{p.proj, p.k_norm_w, pm, pn};
      gemm_unit(lds, mk_rsrc(p.hn), ao, mk_rsrc(p.wt_in + (size_t)(pn * 256) * KDIM), mk_rsrc(p.wt_in + (size_t)(pn * 256 + 32) * KDIM), boK, E, pre, nx, RB0n, RB1n, bon); }
    else { EpiProj E{p.proj, pm, pn, NP};
      gemm_unit(lds, mk_rsrc(p.hn), ao, mk_rsrc(p.wt_in + (size_t)(pn * 256) * KDIM), mk_rsrc(p.wt_in + (size_t)(pn * 256 + 128) * KDIM), bo, E, pre, nx, RB0n, RB1n, bon); }
    pre = nx;
    __syncthreads();
  }
}

template <int KSTEPS> __device__ __forceinline__ f32x4 mma_tile(const LAS bf16_t* A, int lda, const LAS bf16_t* B, int ldb, int fr, int fq) {
  f32x4 c = {0.f, 0.f, 0.f, 0.f};
#pragma unroll
  for (int ks = 0; ks < KSTEPS; ++ks) { const bf16x8 a = *(const LAS bf16x8*)(A + fr * lda + ks * 32 + fq * 8); const bf16x8 b = *(const LAS bf16x8*)(B + fr * ldb + ks * 32 + fq * 8);
    c = __builtin_amdgcn_mfma_f32_16x16x32_bf16(a, b, c, 0, 0, 0); }
  return c;
}

constexpr int G_LQ = 136, G_LK = 72;
constexpr int G1_GD = 0, G1_PART = 4096, G1_QS = 6144, G1_KS = G1_QS + 64 * G_LQ * 2, G1_KHT = G1_KS + 64 * G_LQ * 2, G1_VI = G1_KHT + 128 * G_LK * 2, G1_AS = G1_VI + 64 * 512;
template <int OFF> __device__ __forceinline__ s16x4 trv(int vb) { s16x4 r; asm volatile("ds_read_b64_tr_b16 %0, %1 offset:%2" : "=v"(r) : "v"(vb), "i"(OFF) : "memory"); return r; }
__device__ __forceinline__ void ph_gla1(const Params& p, LAS char* lds) {
  const int tid = otid(), wid = tid >> 6, lane = tid & 63, fr = lane & 15, fq = lane >> 4;
  LAS float* gdS = (LAS float*)(lds + G1_GD); LAS float* partS = (LAS float*)(lds + G1_PART);
  LAS bf16_t* Qs = (LAS bf16_t*)(lds + G1_QS); LAS bf16_t* Ks = (LAS bf16_t*)(lds + G1_KS); LAS bf16_t* Kht = (LAS bf16_t*)(lds + G1_KHT);
  LAS char* VI = lds + G1_VI; LAS bf16_t* As = (LAS bf16_t*)(lds + G1_AS);
  const int q4 = fr >> 2, pp = lane & 3, fv = q4 | ((fq & 1) << 2);
  const int vlane = (int)(unsigned)(uintptr_t)VI + (8 * fq + q4) * 512 + pp * 8;
  int hprev = -1; float Wg[16] = {0.f, 0.f, 0.f, 0.f, 0.f, 0.f, 0.f, 0.f, 0.f, 0.f, 0.f, 0.f, 0.f, 0.f, 0.f, 0.f}; float bias = 0.f;
  u32x4 vv[4], qq[2], kk[2]; f32x4 gg = {0.f, 0.f, 0.f, 0.f};
  auto stage_load = [&](int uu) { const int b2 = uu >> 7, h2 = (uu >> 5) & 3, c2 = uu & 31; const size_t tt = (size_t)b2 * SEQ + c2 * 64;
    if (tid < 256) gg = *(const f32x4*)(p.gd + tt * 16 + tid * 4);
#pragma unroll
    for (int i = 0; i < 4; ++i) { const int pc = tid + i * 512, j = pc >> 5, e8 = (pc & 31) * 8; vv[i] = *(const u32x4*)(p.proj + (tt + j) * NP + 4096 + h2 * 256 + e8); }
#pragma unroll
    for (int i = 0; i < 2; ++i) { const int pc = tid + i * 512, row = pc >> 4, c8 = (pc & 15) * 8; const bf16_t* src = p.proj + (tt + row) * NP + 3072 + h2 * 128 + c8;
      qq[i] = *(const u32x4*)src; kk[i] = *(const u32x4*)(src + 512); } };
  if ((int)blockIdx.x < 512) stage_load(blockIdx.x);
  for (int u = blockIdx.x; u < 512; u += gridDim.x) {
    const int b = u >> 7, h = (u >> 5) & 3, c = u & 31; const size_t t0 = (size_t)b * SEQ + c * 64;
    const int d = tid & 127, qt = tid >> 7;
    if (h != hprev) { hprev = h;
#pragma unroll
      for (int r = 0; r < 16; ++r) Wg[r] = p.gate_up_w[r * 512 + h * 128 + d];
      bias = p.gate_up_b[h * 128 + d]; }
    { if (tid < 256) *(LAS f32x4*)(gdS + tid * 4) = gg;
#pragma unroll
      for (int i = 0; i < 4; ++i) { const int pc = tid + i * 512, j = pc >> 5, e8 = (pc & 31) * 8, fj = (j & 3) | (((j >> 3) & 1) << 2);
        *(LAS u32x4*)(VI + j * 512 + (((e8 >> 4) ^ fj) << 5) + (e8 & 15) * 2) = vv[i]; }
#pragma unroll
      for (int i = 0; i < 2; ++i) { const int pc = tid + i * 512, row = pc >> 4, c8 = (pc & 15) * 8; *(LAS u32x4*)(Qs + row * G_LQ + c8) = qq[i]; *(LAS u32x4*)(Ks + row * G_LQ + c8) = kk[i]; } }
    __syncthreads();
    if (u + (int)gridDim.x < 512) stage_load(u + gridDim.x);
    float bc[16]; float run = 0.f;
#pragma unroll
    for (int ii = 0; ii < 16; ++ii) { const int i = qt * 16 + ii; float xg = bias;
#pragma unroll
      for (int r4 = 0; r4 < 4; ++r4) { const f32x4 g4 = *(const LAS f32x4*)(gdS + i * 16 + r4 * 4); xg += g4[0] * Wg[r4 * 4] + g4[1] * Wg[r4 * 4 + 1] + g4[2] * Wg[r4 * 4 + 2] + g4[3] * Wg[r4 * 4 + 3]; }
      const float ls = fminf(xg, 0.f) - __logf(1.0f + __expf(-fabsf(xg)));
      run += ls * (1.0f / 16.0f); bc[ii] = run; }
    partS[qt * 128 + d] = run;
    __syncthreads();
    float pre = 0.f, tot = 0.f;
#pragma unroll
    for (int q = 0; q < 4; ++q) { const float v = partS[q * 128 + d]; tot += v; pre += (q < qt) ? v : 0.f; }
    const float etot = __expf(tot);
    if (qt == 0) p.decay[u * 128 + d] = etot;
    { unsigned kh[8];
#pragma unroll
      for (int ii = 0; ii < 16; ++ii) { const int i = qt * 16 + ii; const float bb = bc[ii] + pre; const float qv = bf2f(Qs[i * G_LQ + d]), kv = bf2f(Ks[i * G_LQ + d]);
        const float eb = __expf(bb), ib = __builtin_amdgcn_rcpf(eb);
        Qs[i * G_LQ + d] = f2bf(qv * 0.08838834764831845f * eb);
        Ks[i * G_LQ + d] = f2bf(kv * ib);
        const unsigned khv = f2bf(kv * (etot * ib)); if (ii & 1) kh[ii >> 1] |= khv << 16; else kh[ii >> 1] = khv; }
      *(LAS u32x4*)(Kht + d * G_LK + qt * 16) = (u32x4){kh[0], kh[1], kh[2], kh[3]}; *(LAS u32x4*)(Kht + d * G_LK + qt * 16 + 8) = (u32x4){kh[4], kh[5], kh[6], kh[7]}; }
    __syncthreads();
#pragma unroll
    for (int i = 0; i < 2; ++i) { const int pc = tid + i * 512, row = pc >> 4, c8 = (pc & 15) * 8; *(u32x4*)(p.qtil + ((size_t)u * 64 + row) * 128 + c8) = *(const LAS u32x4*)(Qs + row * G_LQ + c8); }
    { const int mt = wid >> 1;
#pragma unroll
      for (int q = 0; q < 2; ++q) { const int nt = (wid & 1) * 2 + q; const f32x4 cc = mma_tile<4>(Qs + mt * 16 * G_LQ, G_LQ, Ks + nt * 16 * G_LQ, G_LQ, fr, fq);
#pragma unroll
        for (int r = 0; r < 4; ++r) { const int i = mt * 16 + fq * 4 + r, j = nt * 16 + fr; As[i * G_LK + j] = f2bf(j <= i ? cc[r] : 0.f); } } }
    __syncthreads();
    { bf16_t* oi = p.oib + (size_t)u * 64 * 256; bf16_t* Uo = p.Ub + (size_t)u * 256 * 128; const int odd = fq & 1, c16 = (odd ? 16 : 0) + 8 * (fq >> 1);
      f32x4 oc[2][4];
#pragma unroll
      for (int q = 0; q < 2; ++q) { const int tq = wid * 2 + q;
        const int va = vlane + ((tq ^ fv) << 5);
        const s16x4 l0 = trv<0>(va), h0 = trv<2048>(va), l1 = trv<16384>(va), h1 = trv<16384 + 2048>(va);
        asm volatile("s_waitcnt lgkmcnt(0)" ::: "memory"); __builtin_amdgcn_sched_barrier(0);
        const bf16x8 vf0 = (bf16x8){l0[0], l0[1], l0[2], l0[3], h0[0], h0[1], h0[2], h0[3]}, vf1 = (bf16x8){l1[0], l1[1], l1[2], l1[3], h1[0], h1[1], h1[2], h1[3]};
#pragma unroll
        for (int mt = 0; mt < 4; ++mt) {
          const bf16x8 a0 = *(const LAS bf16x8*)(As + (mt * 16 + fr) * G_LK + fq * 8), a1 = *(const LAS bf16x8*)(As + (mt * 16 + fr) * G_LK + 32 + fq * 8);
          f32x4 cc = {0.f, 0.f, 0.f, 0.f}; cc = __builtin_amdgcn_mfma_f32_16x16x32_bf16(vf0, a0, cc, 0, 0, 0); cc = __builtin_amdgcn_mfma_f32_16x16x32_bf16(vf1, a1, cc, 0, 0, 0);
          oc[q][mt] = cc; }
#pragma unroll
        for (int np = 0; np < 4; ++np) {
          u32x2 wq[2];
#pragma unroll
          for (int z = 0; z < 2; ++z) { const int nt = np * 2 + z;
            const bf16x8 a0 = *(const LAS bf16x8*)(Kht + (nt * 16 + fr) * G_LK + fq * 8), a1 = *(const LAS bf16x8*)(Kht + (nt * 16 + fr) * G_LK + 32 + fq * 8);
            f32x4 cc = {0.f, 0.f, 0.f, 0.f}; cc = __builtin_amdgcn_mfma_f32_16x16x32_bf16(a0, vf0, cc, 0, 0, 0); cc = __builtin_amdgcn_mfma_f32_16x16x32_bf16(a1, vf1, cc, 0, 0, 0);
            wq[z].x = pkc(cc[0], cc[1]); wq[z].y = pkc(cc[2], cc[3]); }
          u32x4 w; quad_pair16(wq[0], wq[1], odd, w);
          *(u32x4*)(Uo + (tq * 16 + fr) * 128 + np * 32 + c16) = w; } }
#pragma unroll
      for (int mt = 0; mt < 4; ++mt) { u32x2 w0, w1; w0.x = pkc(oc[0][mt][0], oc[0][mt][1]); w0.y = pkc(oc[0][mt][2], oc[0][mt][3]); w1.x = pkc(oc[1][mt][0], oc[1][mt][1]); w1.y = pkc(oc[1][mt][2], oc[1][mt][3]);
        u32x4 w; quad_pair16(w0, w1, odd, w);
        *(u32x4*)(oi + (mt * 16 + fr) * 256 + wid * 32 + c16) = w; } }
    __syncthreads();
  }
}

__device__ __forceinline__ void ph_gla_scan(const Params& p, LAS char* lds) {
  const int tid = otid(); LAS float* decS = (LAS float*)lds;
  for (int w = blockIdx.x; w < 256; w += gridDim.x) {
    const int bh = w >> 4, e = (w & 15) * 16 + ((tid & 255) >> 4), d8 = (tid & 15) * 8;
#pragma unroll
    for (int i = 0; i < 2; ++i) *(LAS f32x4*)(decS + (tid + i * 512) * 4) = *(const f32x4*)(p.decay + (size_t)bh * 4096 + (tid + i * 512) * 4);
    __syncthreads();
    if (tid < 256) {
      f32x4 S0 = {0.f, 0.f, 0.f, 0.f}, S1 = {0.f, 0.f, 0.f, 0.f};
#pragma unroll
      for (int hb = 0; hb < 2; ++hb) { u32x4 uv[16];
#pragma unroll
        for (int c = 0; c < 16; ++c) uv[c] = *(const u32x4*)(p.Ub + ((size_t)(bh * 32 + hb * 16 + c) * 256 + e) * 128 + d8);
#pragma unroll
        for (int c = 0; c < 16; ++c) { const int cc = hb * 16 + c; const size_t off = ((size_t)(bh * 32 + cc) * 256 + e) * 128 + d8;
          u32x4 o; o.x = cvt_pk_bf16(S0[0], S0[1]); o.y = cvt_pk_bf16(S0[2], S0[3]); o.z = cvt_pk_bf16(S1[0], S1[1]); o.w = cvt_pk_bf16(S1[2], S1[3]); *(u32x4*)(p.st + off) = o;
          const u32x4 uu = uv[c]; const f32x4 dc0 = *(const LAS f32x4*)(decS + cc * 128 + d8), dc1 = *(const LAS f32x4*)(decS + cc * 128 + d8 + 4);
          const f32x4 u0 = {bflo(uu.x), bfhi(uu.x), bflo(uu.y), bfhi(uu.y)}, u1 = {bflo(uu.z), bfhi(uu.z), bflo(uu.w), bfhi(uu.w)};
          S0 = dc0 * S0 + u0; S1 = dc1 * S1 + u1; } }
    }
    __syncthreads();
  }
}

constexpr int G3_QS = 0, G3_SS = 64 * G_LQ * 2, G3_OS = 0, G3_LO = 260;
__device__ __forceinline__ void ph_gla3(const Params& p, LAS char* lds) {
  const int tid = otid(), wid = tid >> 6, lane = tid & 63, fr = lane & 15, fq = lane >> 4;
  LAS bf16_t* Qs = (LAS bf16_t*)(lds + G3_QS); LAS bf16_t* Ss = (LAS bf16_t*)(lds + G3_SS); LAS float* Os = (LAS float*)(lds + G3_OS);
  u32x4 qv[2], sv[8];
  auto stage_load = [&](int uu) {
#pragma unroll
    for (int i = 0; i < 2; ++i) { const int pc = tid + i * 512, row = pc >> 4, cc = (pc & 15) * 8; qv[i] = *(const u32x4*)(p.qtil + ((size_t)uu * 64 + row) * 128 + cc); }
#pragma unroll
    for (int i = 0; i < 8; ++i) { const int pc = tid + i * 512, row = pc >> 4, cc = (pc & 15) * 8; sv[i] = *(const u32x4*)(p.st + ((size_t)uu * 256 + row) * 128 + cc); } };
  if ((int)blockIdx.x < 512) stage_load(blockIdx.x);
  LAS float* nwS = (LAS float*)(lds + 102400);
  if (tid < 64) *(LAS f32x4*)(nwS + tid * 4) = *(const f32x4*)(p.gla_norm_w + tid * 4);
  __syncthreads();
  for (int u = blockIdx.x; u < 512; u += gridDim.x) {
    const int b = u >> 7, h = (u >> 5) & 3, c = u & 31; const size_t t0 = (size_t)b * SEQ + c * 64;
#pragma unroll
    for (int i = 0; i < 2; ++i) { const int pc = tid + i * 512, row = pc >> 4, cc = (pc & 15) * 8; *(LAS u32x4*)(Qs + row * G_LQ + cc) = qv[i]; }
#pragma unroll
    for (int i = 0; i < 8; ++i) { const int pc = tid + i * 512, row = pc >> 4, cc = (pc & 15) * 8; *(LAS u32x4*)(Ss + row * G_LQ + cc) = sv[i]; }
    u32x2 obv[2][4]; u32x4 rrv[4];
    { const bf16_t* oi = p.oib + (size_t)u * 64 * 256;
#pragma unroll
      for (int q = 0; q < 2; ++q)
#pragma unroll
        for (int mt = 0; mt < 4; ++mt) obv[q][mt] = *(const u32x2*)(oi + (mt * 16 + fr) * 256 + (wid * 2 + q) * 16 + fq * 4);
      const bf16_t* rp0 = p.proj + (t0 + (tid >> 3)) * NP + 5120 + h * 256 + (tid & 7) * 32;
#pragma unroll
      for (int q = 0; q < 4; ++q) rrv[q] = *(const u32x4*)(rp0 + q * 8); }
    __syncthreads();
    if (u + (int)gridDim.x < 512) stage_load(u + gridDim.x);
    f32x4 res[2][4];
#pragma unroll
    for (int q = 0; q < 2; ++q) { const int nt = wid * 2 + q;
#pragma unroll
      for (int mt = 0; mt < 4; ++mt) { const f32x4 cc = mma_tile<4>(Ss + nt * 16 * G_LQ, G_LQ, Qs + mt * 16 * G_LQ, G_LQ, fr, fq);
        const u32x2 ob = obv[q][mt]; res[q][mt] = cc + (f32x4){bflo(ob.x), bfhi(ob.x), bflo(ob.y), bfhi(ob.y)}; } }
    __syncthreads();
#pragma unroll
    for (int q = 0; q < 2; ++q) { const int nt = wid * 2 + q;
#pragma unroll
      for (int mt = 0; mt < 4; ++mt) *(LAS f32x4*)(Os + (mt * 16 + fr) * G3_LO + nt * 16 + fq * 4) = res[q][mt]; }
    __syncthreads();
    { const int i = tid >> 3, seg = tid & 7; float v[32]; float ss = 0.f;
#pragma unroll
      for (int q = 0; q < 8; ++q) { const f32x4 x = *(const LAS f32x4*)(Os + i * G3_LO + seg * 32 + q * 4); v[q * 4] = x[0]; v[q * 4 + 1] = x[1]; v[q * 4 + 2] = x[2]; v[q * 4 + 3] = x[3]; ss += x[0] * x[0] + x[1] * x[1] + x[2] * x[2] + x[3] * x[3]; }
      ss += __shfl_xor(ss, 1); ss += __shfl_xor(ss, 2); ss += __shfl_xor(ss, 4);
      const float rstd = rsqrtf(ss * (1.0f / 256.0f) + 1e-6f);
      bf16_t* op = p.mix + (t0 + i) * DM + 1024 + h * 256 + seg * 32; const LAS float* nw = nwS + seg * 32;
#pragma unroll
      for (int q = 0; q < 4; ++q) { const u32x4 rr = rrv[q]; const float rf[8] = {bflo(rr.x), bfhi(rr.x), bflo(rr.y), bfhi(rr.y), bflo(rr.z), bfhi(rr.z), bflo(rr.w), bfhi(rr.w)}; float o8[8];
#pragma unroll
        for (int j = 0; j < 8; ++j) { const float r = rf[j]; const float sl = r * __builtin_amdgcn_rcpf(1.0f + __expf(-r)); o8[j] = v[q * 8 + j] * rstd * nw[q * 8 + j] * sl; }
        u32x4 w; w.x = cvt_pk_bf16(o8[0], o8[1]); w.y = cvt_pk_bf16(o8[2], o8[3]); w.z = cvt_pk_bf16(o8[4], o8[5]); w.w = cvt_pk_bf16(o8[6], o8[7]); *(u32x4*)(op + q * 8) = w; } }
    __syncthreads();
  }
}

constexpr int SHM_KV = 64 * 128 * 2;
#define KSWZ(row, colB) ((row) * 256 + ((colB) ^ (((row) & 7) << 4)))
#define SBAR() __builtin_amdgcn_sched_barrier(0)
__device__ __forceinline__ int crow(int r, int hi) { return (r & 3) + 8 * (r >> 2) + 4 * hi; }
constexpr float ATT_THR = 14.0f;
template <bool FAST> __device__ __forceinline__ void partialSM(f32x16& p0, f32x16& p1, float& m_reg, float& mn, float& alpha) {
  if constexpr (FAST) {
#pragma unroll
    for (int r = 0; r < 16; ++r) p0[r] = __builtin_amdgcn_exp2f(p0[r]);
    return; }
  float pmax = p0[0];
#pragma unroll
  for (int r = 1; r < 16; ++r) pmax = fmaxf(pmax, p0[r]);
#pragma unroll
  for (int r = 0; r < 16; ++r) pmax = fmaxf(pmax, p1[r]);
  { auto rr = __builtin_amdgcn_permlane32_swap(__float_as_uint(pmax), __float_as_uint(pmax), false, false); pmax = fmaxf(__uint_as_float(rr[0]), __uint_as_float(rr[1])); }
  if (__builtin_expect(__all(pmax - m_reg <= ATT_THR), 1)) { mn = m_reg; alpha = 1.f; }
  else { mn = fmaxf(m_reg, pmax); alpha = __builtin_amdgcn_exp2f(m_reg - mn); m_reg = mn; }
#pragma unroll
  for (int r = 0; r < 16; ++r) p0[r] = p0[r] - mn;
#pragma unroll
  for (int r = 0; r < 16; ++r) p1[r] = p1[r] - mn;
#pragma unroll
  for (int r = 0; r < 16; ++r) p0[r] = __builtin_amdgcn_exp2f(p0[r]);
}
template <bool FAST> __device__ __forceinline__ void finishSM(f32x16& p0, f32x16& p1, float alpha, float& l_reg, bf16x8& pa0, bf16x8& pa1, bf16x8& pa2, bf16x8& pa3) {
#pragma unroll
  for (int r = 0; r < 16; ++r) p1[r] = __builtin_amdgcn_exp2f(p1[r]);
  float ps = 0;
#pragma unroll
  for (int r = 0; r < 16; ++r) ps += p0[r];
#pragma unroll
  for (int r = 0; r < 16; ++r) ps += p1[r];
  { auto rr = __builtin_amdgcn_permlane32_swap(__float_as_uint(ps), __float_as_uint(ps), false, false); ps = __uint_as_float(rr[0]) + __uint_as_float(rr[1]); }
  if constexpr (FAST) l_reg += ps; else l_reg = l_reg * alpha + ps;
#define PK4(P, BASE, OUT) do { unsigned a0 = cvt_pk_bf16(P[BASE + 0], P[BASE + 1]), a1 = cvt_pk_bf16(P[BASE + 2], P[BASE + 3]);   \
    unsigned b0 = cvt_pk_bf16(P[BASE + 4], P[BASE + 5]), b1 = cvt_pk_bf16(P[BASE + 6], P[BASE + 7]);                              \
    auto r0 = __builtin_amdgcn_permlane32_swap(a0, b0, false, false); auto r1 = __builtin_amdgcn_permlane32_swap(a1, b1, false, false); \
    u32x4 w = {r0[0], r1[0], r0[1], r1[1]}; OUT = *reinterpret_cast<bf16x8*>(&w); } while (0)
  PK4(p0, 0, pa0); PK4(p0, 8, pa1); PK4(p1, 0, pa2); PK4(p1, 8, pa3);
#undef PK4
}
__device__ __forceinline__ void qkt(f32x16& p0, f32x16& p1, const LAS char* Ks, const bf16x8* qr, int r32, int hi, int mapc) {
  p0 = f32x16{}; p1 = f32x16{};
#pragma unroll
  for (int d0 = 0; d0 < 4; ++d0) { const int cb = (mapc + d0 * 16 + hi * 8) * 2;
    const bf16x8 b0 = *(const LAS bf16x8*)(Ks + KSWZ(r32, cb));
    const bf16x8 b1 = *(const LAS bf16x8*)(Ks + KSWZ(32 + r32, cb));
    p0 = __builtin_amdgcn_mfma_f32_32x32x16_bf16(b0, qr[d0], p0, 0, 0, 0);
    p1 = __builtin_amdgcn_mfma_f32_32x32x16_bf16(b1, qr[d0], p1, 0, 0, 0); }
}
__device__ __forceinline__ int v_st(int k, int c) { const int kk = (k & ~0xC) | ((k & 4) << 1) | ((k & 8) >> 1); return ((kk >> 3) * 4 + (c >> 5)) * 512 + ((kk & 7) * 32 + (c & 31)) * 2; }
__device__ __forceinline__ int v_rd_base(int lane) { return ((lane & 3) << 3) | (((lane >> 2) & 3) << 6) | (((lane >> 4) & 1) << 5) | (((lane >> 5) & 1) << 8); }
constexpr int v_rd_off(int d0, int ks, int half) { return d0 * 512 + ks * 4096 + half * 2048; }
template <int OFF> __device__ __forceinline__ s16x4 tr_read(int vb) { s16x4 r; asm volatile("ds_read_b64_tr_b16 %0, %1 offset:%2" : "=&v"(r) : "v"(vb), "i"(OFF) : "memory"); return r; }
template <int D0> __device__ __forceinline__ void pv_one(f32x16& od, int vb, bf16x8 pa0, bf16x8 pa1, bf16x8 pa2, bf16x8 pa3) {
  const s16x4 l0 = tr_read<v_rd_off(D0, 0, 0)>(vb), h0 = tr_read<v_rd_off(D0, 0, 1)>(vb), l1 = tr_read<v_rd_off(D0, 1, 0)>(vb), h1 = tr_read<v_rd_off(D0, 1, 1)>(vb);
  const s16x4 l2 = tr_read<v_rd_off(D0, 2, 0)>(vb), h2 = tr_read<v_rd_off(D0, 2, 1)>(vb), l3 = tr_read<v_rd_off(D0, 3, 0)>(vb), h3 = tr_read<v_rd_off(D0, 3, 1)>(vb);
  asm volatile("s_waitcnt lgkmcnt(0)" ::: "memory"); SBAR();
#define PK(L, H) (bf16x8){L[0], L[1], L[2], L[3], H[0], H[1], H[2], H[3]}
  od = __builtin_amdgcn_mfma_f32_32x32x16_bf16(pa0, PK(l0, h0), od, 0, 0, 0);
  od = __builtin_amdgcn_mfma_f32_32x32x16_bf16(pa1, PK(l1, h1), od, 0, 0, 0);
  od = __builtin_amdgcn_mfma_f32_32x32x16_bf16(pa2, PK(l2, h2), od, 0, 0, 0);
  od = __builtin_amdgcn_mfma_f32_32x32x16_bf16(pa3, PK(l3, h3), od, 0, 0, 0);
#undef PK
}
__device__ __forceinline__ void pv_d0(f32x16* o, int vb, bf16x8 pa0, bf16x8 pa1, bf16x8 pa2, bf16x8 pa3) {
  pv_one<0>(o[0], vb, pa0, pa1, pa2, pa3); pv_one<1>(o[1], vb, pa0, pa1, pa2, pa3); pv_one<2>(o[2], vb, pa0, pa1, pa2, pa3); pv_one<3>(o[3], vb, pa0, pa1, pa2, pa3);
}

template <bool FAST> __device__ __forceinline__ void attn_unit(const Params& p, LAS char* lds, int b, int h, int qb, float lam) {
  const int tid = otid(), wid = __builtin_amdgcn_readfirstlane(tid >> 6), lane = tid & 63, r32 = lane & 31, hi = lane >> 5;
  const int map = wid >> 2, wq = wid & 3, mapc = map * 64;
  LAS char* V_lds = lds; LAS char* K_lds = lds + 3 * SHM_KV;
  LAS float* wsf = (LAS float*)(lds + 6 * SHM_KV) + wid * 64; LAS float* li_l = wsf; LAS float* al_l = wsf + 32;
  const int i0 = qb * 128, NT = 2 * qb + 2; const bool masked = (wq < 2);
  float m_reg = -1e30f, l_reg = 0; f32x16 o[4] = {}; bf16x8 qr[4];
  const bf16_t* Qw = p.proj + ((size_t)b * SEQ + i0 + wq * 32 + r32) * NP + h * 128 + mapc + hi * 8;
  {
    u32x4 qraw[4]; float qf[4][8]; float ss = 0.f;
#pragma unroll
    for (int d0 = 0; d0 < 4; ++d0) qraw[d0] = *(const u32x4*)(Qw + d0 * 16);
#pragma unroll
    for (int d0 = 0; d0 < 4; ++d0) { const u32x4 r = qraw[d0]; qf[d0][0] = bflo(r.x); qf[d0][1] = bfhi(r.x); qf[d0][2] = bflo(r.y); qf[d0][3] = bfhi(r.y); qf[d0][4] = bflo(r.z); qf[d0][5] = bfhi(r.z); qf[d0][6] = bflo(r.w); qf[d0][7] = bfhi(r.w);
#pragma unroll
      for (int j = 0; j < 8; ++j) ss += qf[d0][j] * qf[d0][j]; }
    ss += __shfl_xor(ss, 32);
    const float rs = rsqrtf(ss * (1.0f / 64.0f) + 1e-6f) * (0.125f * 1.4426950408889634f);
#pragma unroll
    for (int d0 = 0; d0 < 4; ++d0) { const f32x4 w0 = *(const f32x4*)(p.q_norm_w + d0 * 16 + hi * 8), w1 = *(const f32x4*)(p.q_norm_w + d0 * 16 + hi * 8 + 4);
      u32x4 o; o.x = cvt_pk_bf16(qf[d0][0] * rs * w0[0], qf[d0][1] * rs * w0[1]); o.y = cvt_pk_bf16(qf[d0][2] * rs * w0[2], qf[d0][3] * rs * w0[3]);
      o.z = cvt_pk_bf16(qf[d0][4] * rs * w1[0], qf[d0][5] * rs * w1[1]); o.w = cvt_pk_bf16(qf[d0][6] * rs * w1[2], qf[d0][7] * rs * w1[3]);
      qr[d0] = *reinterpret_cast<bf16x8*>(&o); } }
  const rsrc_t RK = mk_rsrc(p.proj + (size_t)b * SEQ * NP + 1024 + h * 128);
  const int sr = tid >> 4, sc = (tid & 15) * 8, vst0 = v_st(sr, sc), vst1 = v_st(32 + sr, sc); const unsigned soff = (unsigned)(sr * NP + sc) * 2u;
  const int vb0 = (int)(unsigned)(uintptr_t)V_lds + v_rd_base(lane);
  struct { bf16x8 vs0, vs1, ks0, ks1; } sr_[2];
#define BL128(so) ({ u32x4 _t = __builtin_amdgcn_raw_buffer_load_b128(RK, (int)soff, (int)(so), 0); *reinterpret_cast<bf16x8*>(&_t); })
#define SLOAD(i, k0) do { const unsigned _s0 = (unsigned)(k0) * (NP * 2), _s1 = _s0 + 32 * NP * 2; \
    sr_[i].vs0 = BL128(_s0 + 2048); sr_[i].vs1 = BL128(_s1 + 2048); sr_[i].ks0 = BL128(_s0); sr_[i].ks1 = BL128(_s1); } while (0)
#define SWRITE(off, i) do { *(LAS bf16x8*)(V_lds + (off) + vst0) = sr_[i].vs0; *(LAS bf16x8*)(V_lds + (off) + vst1) = sr_[i].vs1; const int kc = sc * 2; \
    *(LAS bf16x8*)(K_lds + (off) + KSWZ(sr, kc)) = sr_[i].ks0; *(LAS bf16x8*)(K_lds + (off) + KSWZ(32 + sr, kc)) = sr_[i].ks1; } while (0)
#define SWAIT() asm volatile("s_waitcnt vmcnt(4)" ::: "memory")
#define RESC(a) do { if constexpr (!FAST) if (__any((a) < 1.f)) { if (hi == 0) al_l[r32] = (a); asm volatile("s_waitcnt lgkmcnt(0)" ::: "memory"); \
    _Pragma("unroll") for (int d = 0; d < 4; ++d) _Pragma("unroll") for (int r = 0; r < 16; ++r) o[d][r] *= al_l[crow(r, hi)]; } } while (0)
  f32x16 pA0, pA1, pB0, pB1; float mnA = 0.f, mnB = 0.f, alA = 1.f, alB = 1.f; bf16x8 pa0, pa1, pa2, pa3;
  int offV = 0, offK = SHM_KV, offW = 2 * SHM_KV;
#define ROT3() do { const int _t = offV; offV = offK; offK = offW; offW = _t; } while (0)
  SLOAD(0, 0); asm volatile("s_waitcnt vmcnt(0)" ::: "memory"); SWRITE(0, 0); __syncthreads();
  qkt(pA0, pA1, K_lds, qr, r32, hi, mapc); partialSM<FAST>(pA0, pA1, m_reg, mnA, alA);
  SLOAD(1, 64); if (2 < NT) SLOAD(0, 128);
  SWAIT(); SWRITE(SHM_KV, 1); __syncthreads();
  for (int j = 1; j + 1 < NT; j += 2) {
    SBAR(); qkt(pB0, pB1, K_lds + offK, qr, r32, hi, mapc);
    finishSM<FAST>(pA0, pA1, alA, l_reg, pa0, pa1, pa2, pa3); SBAR();
    SLOAD(1, (j + 2) * 64); SBAR();
    pv_d0(o, vb0 + offV, pa0, pa1, pa2, pa3); partialSM<FAST>(pB0, pB1, m_reg, mnB, alB);
    SWAIT(); SWRITE(offW, 0);
    RESC(alB); __syncthreads(); ROT3();
    SBAR(); qkt(pA0, pA1, K_lds + offK, qr, r32, hi, mapc);
    finishSM<FAST>(pB0, pB1, alB, l_reg, pa0, pa1, pa2, pa3); SBAR();
    if (j + 3 < NT) SLOAD(0, (j + 3) * 64); SBAR();
    pv_d0(o, vb0 + offV, pa0, pa1, pa2, pa3); partialSM<FAST>(pA0, pA1, m_reg, mnA, alA);
    SWAIT(); SWRITE(offW, 1);
    RESC(alA); __syncthreads(); ROT3();
  }
  SBAR(); qkt(pB0, pB1, K_lds + offK, qr, r32, hi, mapc);
  if (masked) {
#pragma unroll
    for (int r = 0; r < 16; ++r) { pB0[r] = -1e30f; pB1[r] = -1e30f; } }
  finishSM<FAST>(pA0, pA1, alA, l_reg, pa0, pa1, pa2, pa3); SBAR();
  pv_d0(o, vb0 + offV, pa0, pa1, pa2, pa3); partialSM<FAST>(pB0, pB1, m_reg, mnB, alB);
  RESC(alB);
  finishSM<FAST>(pB0, pB1, alB, l_reg, pa0, pa1, pa2, pa3); SBAR();
  pv_d0(o, vb0 + offK, pa0, pa1, pa2, pa3);
#undef ROT3
  if (hi == 0) li_l[r32] = l_reg; asm volatile("s_waitcnt lgkmcnt(0)" ::: "memory");
  const float sgn = map ? -lam : 1.0f;
#pragma unroll
  for (int r = 0; r < 16; ++r) { const float rl = __builtin_amdgcn_rcpf(li_l[crow(r, hi)]) * sgn;
#pragma unroll
    for (int d = 0; d < 4; ++d) o[d][r] *= rl; }
  __syncthreads();
  LAS float* xch = (LAS float*)lds;
  if (map == 1) {
#pragma unroll
    for (int d = 0; d < 4; ++d)
#pragma unroll
      for (int r = 0; r < 16; ++r) xch[(wq * 64 + d * 16 + r) * 64 + lane] = o[d][r]; }
  __syncthreads();
  if (map == 0) {
    float subw[4];
#pragma unroll
    for (int d = 0; d < 4; ++d) subw[d] = p.subln_w[d * 32 + r32] * 0.8f;
#pragma unroll
    for (int r = 0; r < 16; ++r) { float ss = 0.f;
#pragma unroll
      for (int d = 0; d < 4; ++d) { o[d][r] += xch[(wq * 64 + d * 16 + r) * 64 + lane]; ss += o[d][r] * o[d][r]; }
      ss += __shfl_xor(ss, 1); ss += __shfl_xor(ss, 2); ss += __shfl_xor(ss, 4); ss += __shfl_xor(ss, 8); ss += __shfl_xor(ss, 16);
      const float rs = rsqrtf(ss * (1.0f / 128.0f) + 1e-6f);
#pragma unroll
      for (int d = 0; d < 4; ++d) xch[(wq * 64 + d * 16 + r) * 64 + lane] = o[d][r] * rs * subw[d]; }
  }
  __syncthreads();
#pragma unroll
  for (int it = 0; it < 4; ++it) { const int idx = it * 512 + tid, c8 = idx & 15, row = idx >> 4, wq2 = row >> 5, rho = row & 31;
    const int r = (rho & 3) + 4 * (rho >> 3), hi2 = (rho >> 2) & 1, d = c8 >> 2;
    const LAS float* src = xch + (wq2 * 64 + d * 16 + r) * 64 + hi2 * 32 + (c8 & 3) * 8;
    const f32x4 v0 = *(const LAS f32x4*)src, v1 = *(const LAS f32x4*)(src + 4);
    u32x4 w; w.x = cvt_pk_bf16(v0[0], v0[1]); w.y = cvt_pk_bf16(v0[2], v0[3]); w.z = cvt_pk_bf16(v1[0], v1[1]); w.w = cvt_pk_bf16(v1[2], v1[3]);
    *(u32x4*)(p.mix + ((size_t)b * SEQ + i0 + row) * DM + h * 128 + c8 * 8) = w; }
  __syncthreads();
#undef SLOAD
#undef BL128
#undef SWRITE
#undef SWAIT
#undef RESC
}
__device__ __forceinline__ void ph_attn(const Params& p, LAS char* lds) {
  const int lane = otid() & 63;
  const float s1 = wave_sum(p.lq1[lane] * p.lk1[lane]), s2 = wave_sum(p.lq2[lane] * p.lk2[lane]);
  const float lam = expf(s1) - expf(s2) + 0.2f;
  float mq = fabsf(p.q_norm_w[lane]), mk = fabsf(p.k_norm_w[lane]);
#pragma unroll
  for (int o = 1; o < 64; o <<= 1) { mq = fmaxf(mq, __shfl_xor(mq, o)); mk = fmaxf(mk, __shfl_xor(mk, o)); }
  const float bound = 64.0f * 0.125f * 1.4426950408889634f * 1.01f * mq * mk;
  const bool fast = __builtin_amdgcn_readfirstlane(bound <= 24.0f ? 1 : 0) != 0;
  for (int u = blockIdx.x; u < 256; u += gridDim.x) {
    const int b = u >> 6, h = (u >> 3) & 7, pq = u & 7;
    if (fast) { for (int hh = 0; hh < 2; ++hh) attn_unit<true>(p, lds, b, h, hh ? pq : 15 - pq, lam); }
    else { for (int hh = 0; hh < 2; ++hh) attn_unit<false>(p, lds, b, h, hh ? pq : 15 - pq, lam); }
  }
}

__device__ __forceinline__ void ph_outproj(const Params& p, LAS char* lds) {
  unsigned bo[2]; b_offsets<true>(bo);
  for (int u = blockIdx.x; u < 32 * 8; u += gridDim.x) {
    const int pm = u & 31, pn = u >> 5;
    unsigned ao[2][2];
#pragma unroll
    for (int h = 0; h < 2; ++h)
#pragma unroll
      for (int i = 0; i < 2; ++i) { int R, C; stage_rc(otid() * 16 + i * 8192, R, C); ao[h][i] = (unsigned)((pm * 256 + h * 128 + R) * KDIM + C) * 2u; }
    EpiProj E{p.hn, pm, pn, DM};
    gemm_unit(lds, mk_rsrc(p.mix), ao, mk_rsrc(p.wt_out + (size_t)(pn * 256) * KDIM), mk_rsrc(p.wt_out + (size_t)(pn * 256 + 128) * KDIM), bo, E);
    __syncthreads();
  }
}

__device__ __forceinline__ void ph_router(const Params& p, LAS char* lds) {
  const int tid = otid(), kq = tid >> 6, lane = tid & 63, fr = lane & 15, fq = lane >> 4;
  LAS float* ssq = (LAS float*)lds;
  LAS float* part = (LAS float*)(lds + 1024);
  LAS float* nwS = (LAS float*)(lds + 40960);
  *(LAS f32x4*)(nwS + tid * 4) = *(const f32x4*)(p.ffn_norm_w + tid * 4);
  __syncthreads();
  for (int task = blockIdx.x; task < T_TOK / 32; task += gridDim.x) {
    f32x4 ha[2][8], hb[2][8];
#pragma unroll
    for (int rt = 0; rt < 2; ++rt) { const size_t ro = (size_t)(task * 32 + rt * 16 + fr) * DM + kq * 256 + fq * 8; const float* xr = p.x + ro; const bf16_t* ar = p.hn + ro;
#pragma unroll
      for (int ks = 0; ks < 8; ++ks) { const u32x4 av = *(const u32x4*)(ar + ks * 32);
        ha[rt][ks] = *(const f32x4*)(xr + ks * 32) + (f32x4){bflo(av.x), bfhi(av.x), bflo(av.y), bfhi(av.y)}; hb[rt][ks] = *(const f32x4*)(xr + ks * 32 + 4) + (f32x4){bflo(av.z), bfhi(av.z), bflo(av.w), bfhi(av.w)}; }
      __builtin_amdgcn_sched_barrier(0); }
#pragma unroll
    for (int rt = 0; rt < 2; ++rt) { float ss = 0.f;
#pragma unroll
      for (int ks = 0; ks < 8; ++ks) { const f32x4 a = ha[rt][ks], c = hb[rt][ks]; ss += a[0] * a[0] + a[1] * a[1] + a[2] * a[2] + a[3] * a[3] + c[0] * c[0] + c[1] * c[1] + c[2] * c[2] + c[3] * c[3]; }
      ss += __shfl_xor(ss, 16); ss += __shfl_xor(ss, 32);
      if (fq == 0) ssq[(rt * 8 + kq) * 16 + fr] = ss; }
    __syncthreads();
    float rstd[2];
#pragma unroll
    for (int rt = 0; rt < 2; ++rt) { float tot = 0.f;
#pragma unroll
      for (int q = 0; q < 8; ++q) tot += ssq[(rt * 8 + q) * 16 + fr];
      rstd[rt] = rsqrtf(tot * (1.0f / 2048.0f) + 1e-6f); }
    f32x4 acc[2][2];
#pragma unroll
    for (int rt = 0; rt < 2; ++rt) { acc[rt][0] = (f32x4){0.f, 0.f, 0.f, 0.f}; acc[rt][1] = (f32x4){0.f, 0.f, 0.f, 0.f}; }
    const bf16_t* wh0 = p.wr_hi + fr * 2048 + kq * 256 + fq * 8; const bf16_t* wl0 = p.wr_lo + fr * 2048 + kq * 256 + fq * 8;
    const LAS float* nwp = nwS + kq * 256 + fq * 8;
#pragma unroll
    for (int ks = 0; ks < 8; ++ks) {
      const f32x4 wa = *(const LAS f32x4*)(nwp + ks * 32), wc = *(const LAS f32x4*)(nwp + ks * 32 + 4);
      const bf16x8 bh0 = *(const bf16x8*)(wh0 + ks * 32), bh1 = *(const bf16x8*)(wh0 + 16 * 2048 + ks * 32), bl0 = *(const bf16x8*)(wl0 + ks * 32), bl1 = *(const bf16x8*)(wl0 + 16 * 2048 + ks * 32);
#pragma unroll
      for (int rt = 0; rt < 2; ++rt) {
        const f32x4 a = ha[rt][ks], c = hb[rt][ks]; const float rs = rstd[rt];
        float t[8] = {a[0] * rs * wa[0], a[1] * rs * wa[1], a[2] * rs * wa[2], a[3] * rs * wa[3], c[0] * rs * wc[0], c[1] * rs * wc[1], c[2] * rs * wc[2], c[3] * rs * wc[3]};
        u32x4 hi4, lo4;
        hi4.x = cvt_pk_bf16(t[0], t[1]); hi4.y = cvt_pk_bf16(t[2], t[3]); hi4.z = cvt_pk_bf16(t[4], t[5]); hi4.w = cvt_pk_bf16(t[6], t[7]);
        lo4.x = cvt_pk_bf16(t[0] - bflo(hi4.x), t[1] - bfhi(hi4.x)); lo4.y = cvt_pk_bf16(t[2] - bflo(hi4.y), t[3] - bfhi(hi4.y));
        lo4.z = cvt_pk_bf16(t[4] - bflo(hi4.z), t[5] - bfhi(hi4.z)); lo4.w = cvt_pk_bf16(t[6] - bflo(hi4.w), t[7] - bfhi(hi4.w));
        *(u32x4*)(p.tb + (size_t)(task * 32 + rt * 16 + fr) * DM + kq * 256 + fq * 8 + ks * 32) = hi4;
        const bf16x8 ah = *reinterpret_cast<bf16x8*>(&hi4), al = *reinterpret_cast<bf16x8*>(&lo4);
        acc[rt][0] = __builtin_amdgcn_mfma_f32_16x16x32_bf16(ah, bh0, acc[rt][0], 0, 0, 0); acc[rt][0] = __builtin_amdgcn_mfma_f32_16x16x32_bf16(ah, bl0, acc[rt][0], 0, 0, 0); acc[rt][0] = __builtin_amdgcn_mfma_f32_16x16x32_bf16(al, bh0, acc[rt][0], 0, 0, 0);
        acc[rt][1] = __builtin_amdgcn_mfma_f32_16x16x32_bf16(ah, bh1, acc[rt][1], 0, 0, 0); acc[rt][1] = __builtin_amdgcn_mfma_f32_16x16x32_bf16(ah, bl1, acc[rt][1], 0, 0, 0); acc[rt][1] = __builtin_amdgcn_mfma_f32_16x16x32_bf16(al, bh1, acc[rt][1], 0, 0, 0);
      }
    }
#pragma unroll
    for (int rt = 0; rt < 2; ++rt) { LAS float* pw_ = part + (rt * 8 + kq) * (16 * 33);
#pragma unroll
      for (int r = 0; r < 4; ++r) { pw_[(fq * 4 + r) * 33 + fr] = acc[rt][0][r]; pw_[(fq * 4 + r) * 33 + 16 + fr] = acc[rt][1][r]; } }
    __syncthreads();
    if (kq < 2 && lane < 16) { const int rt = kq;
      float v[32]; const LAS float* pr_ = part + (rt * 8) * (16 * 33) + lane * 33;
#pragma unroll
      for (int e = 0; e < 32; ++e) { float sacc = p.router_b[e];
#pragma unroll
        for (int q = 0; q < 8; ++q) sacc += pr_[q * 16 * 33 + e];
        v[e] = sacc; }
      float tv[4]; int ti[4];
#pragma unroll
      for (int k = 0; k < 4; ++k) { float best = -3.0e38f; int bi = 0;
#pragma unroll
        for (int e = 0; e < 32; ++e) { if (v[e] > best) { best = v[e]; bi = e; } }
        tv[k] = best; ti[k] = bi;
#pragma unroll
        for (int e = 0; e < 32; ++e) v[e] = (e == bi) ? -3.0e38f : v[e]; }
      const float e1 = expf(tv[1] - tv[0]), e2 = expf(tv[2] - tv[0]), e3 = expf(tv[3] - tv[0]); const float inv = 1.0f / (1.0f + e1 + e2 + e3);
      const float wk[4] = {inv, e1 * inv, e2 * inv, e3 * inv};
      const int tok = task * 32 + rt * 16 + lane;
#pragma unroll
      for (int k = 0; k < 4; ++k) { const unsigned slot = __hip_atomic_fetch_add(p.cnt + ti[k], 1u, __ATOMIC_RELAXED, __HIP_MEMORY_SCOPE_AGENT);
        p.list[ti[k] * CAP + (int)slot] = tok * 4 + k; p.pw[tok * 4 + k] = wk[k]; }
    }
    __syncthreads();
  }
}

struct MoeTab { int cnt[32]; int base[33]; };
template <int NPL> __device__ __forceinline__ void moe_table(const Params& p, LAS MoeTab* tb) {
  if (otid() < 32) tb->cnt[otid()] = (int)__hip_atomic_load(p.cnt + otid(), __ATOMIC_RELAXED, __HIP_MEMORY_SCOPE_AGENT);
  __syncthreads();
  if (otid() == 0) { int s = 0; for (int e = 0; e < 32; ++e) { tb->base[e] = s; s += ((tb->cnt[e] + 255) >> 8) * NPL; } tb->base[32] = s; }
  __syncthreads();
}
struct EpiAct { rsrc_t RO; const LAS float* biasS; const LAS int* pairS; int pn;
  __device__ __forceinline__ void init(f32x4 (&acc)[2][2][4][2], int wc, int fq) const {
    const int cl = wc * 32 + 4 * fq;
#pragma unroll
    for (int bj = 0; bj < 2; ++bj)
#pragma unroll
      for (int n = 0; n < 2; ++n) { const f32x4 bv = *(const LAS f32x4*)(biasS + bj * 128 + cl + n * 16);
#pragma unroll
        for (int ai = 0; ai < 2; ++ai)
#pragma unroll
          for (int m = 0; m < 4; ++m) acc[ai][bj][m][n] = bv; }
  }
  template <int AI, int M0, int M1> __device__ __forceinline__ void part(const f32x4 (&acc)[2][2][4][2], int wr, int wc, int fr, int fq) const {
    const int odd = fq & 1, cs = pn * 128 + wc * 32 + (odd ? 16 : 0) + 8 * (fq >> 1);
    { constexpr int ai = AI;
#pragma unroll
      for (int m = M0; m < M1; ++m) { const int pr = pairS[ai * 128 + wr * 64 + m * 16 + fr];
        if (!__any(pr >= 0)) continue;
        u32x2 wq[2];
#pragma unroll
        for (int n = 0; n < 2; ++n) {
          f32x4 g = acc[ai][0][m][n], uu = acc[ai][1][m][n], e;
#pragma unroll
          for (int j = 0; j < 4; ++j) { g[j] = __builtin_amdgcn_fmed3f(g[j], -__builtin_inff(), 7.0f); uu[j] = __builtin_amdgcn_fmed3f(uu[j], -7.0f, 7.0f); }
          const f32x4 ta = g * (-1.702f * 1.4426950408889634f);
#pragma unroll
          for (int j = 0; j < 4; ++j) e[j] = __builtin_amdgcn_exp2f(ta[j]);
          e = e + 1.0f;
#pragma unroll
          for (int j = 0; j < 4; ++j) e[j] = __builtin_amdgcn_rcpf(e[j]);
          const f32x4 r4 = (uu + 1.0f) * g * e;
          wq[n].x = cvt_pk_bf16(r4[0], r4[1]); wq[n].y = cvt_pk_bf16(r4[2], r4[3]); }
        u32x4 w; quad_pair16(wq[0], wq[1], odd, w);
        if (pr >= 0) __builtin_amdgcn_raw_buffer_store_b128(w, RO, (unsigned)(pr * DM + cs) * 2u, 0, 16); } }
  } };
struct EpiY { bf16_t* O; const LAS float* biasS; const LAS float* pwS; const LAS int* pairS; int pn;
  __device__ __forceinline__ void init(f32x4 (&acc)[2][2][4][2], int wc, int fq) const {
    const int cl = wc * 32 + 4 * fq;
#pragma unroll
    for (int bj = 0; bj < 2; ++bj)
#pragma unroll
      for (int n = 0; n < 2; ++n) { const f32x4 bv = *(const LAS f32x4*)(biasS + cl + bj * 128 + n * 16);
#pragma unroll
        for (int ai = 0; ai < 2; ++ai)
#pragma unroll
          for (int m = 0; m < 4; ++m) acc[ai][bj][m][n] = bv; }
  }
  template <int AI, int M0, int M1> __device__ __forceinline__ void part(const f32x4 (&acc)[2][2][4][2], int wr, int wc, int fr, int fq) const {
    const int odd = fq & 1, cs = pn * 256 + wc * 32 + (odd ? 16 : 0) + 8 * (fq >> 1);
    { constexpr int ai = AI;
#pragma unroll
      for (int m = M0; m < M1; ++m) { const int rl = ai * 128 + wr * 64 + m * 16 + fr; const int pr = pairS[rl]; const float wgt = pwS[rl];
        if (!__any(pr >= 0)) continue;
#pragma unroll
        for (int bj = 0; bj < 2; ++bj) { u32x2 wq[2];
#pragma unroll
          for (int n = 0; n < 2; ++n) { const f32x4 v0 = acc[ai][bj][m][n] * wgt; wq[n].x = cvt_pk_bf16(v0[0], v0[1]); wq[n].y = cvt_pk_bf16(v0[2], v0[3]); }
          u32x4 w; quad_pair16(wq[0], wq[1], odd, w);
          if (pr >= 0) *(u32x4*)(O + (size_t)pr * DM + cs + bj * 128) = w; } } }
  } };
__device__ __forceinline__ void ph_moe_all(const Params& p, LAS char* lds) {
  LAS MoeTab* tb = (LAS MoeTab*)(lds + LDS_MISC); LAS int* pairS = (LAS int*)(lds + LDS_PAIR); LAS int* qS = (LAS int*)(lds + LDS_MISC + 512);
  moe_table<1>(p, tb);
  const int Mt = __builtin_amdgcn_readfirstlane(tb->base[32]), total = 3 * Mt;
  const int xl = blockIdx.x & 7;
  unsigned* qh = p.bar + CW_QHEAD + 16 * xl; unsigned* tmo = p.bar + CW_TMO;
  if (otid() == 0) qS[0] = (int)__hip_atomic_fetch_add(qh, 1u, __ATOMIC_RELAXED, __HIP_MEMORY_SCOPE_AGENT);
  __syncthreads();
  for (;;) {
    const int ent = __builtin_amdgcn_readfirstlane(qS[0]);
    if (ent >= total) break;
    unsigned nxt = 0u;
    if (otid() == 0) nxt = __hip_atomic_fetch_add(qh, 1u, __ATOMIC_RELAXED, __HIP_MEMORY_SCOPE_AGENT);
    const int which = ent >= 2 * Mt ? 1 : 0, idx0 = which ? ent - 2 * Mt : ent, npl = which ? 1 : 2;
    const int lq = otid() & 31;
    const unsigned long long bal = __ballot(idx0 >= tb->base[lq] * npl);
    const int e = __builtin_amdgcn_readfirstlane(__popcll(bal & 0xffffffffull) - 1);
    const int ce = __builtin_amdgcn_readfirstlane(tb->cnt[e]), mte = (ce + 255) >> 8, idx = idx0 - __builtin_amdgcn_readfirstlane(tb->base[e]) * npl, pnl = idx / mte, mt = idx - pnl * mte, pn = xl + 8 * pnl;
    unsigned* dn = p.bar + CW_DONE + 16 * (e * 32 + mt);
    if (which && otid() < 64) {
      unsigned sp = 0;
      while (__builtin_amdgcn_readfirstlane(__hip_atomic_load(dn, __ATOMIC_RELAXED, __HIP_MEMORY_SCOPE_AGENT)) < 16u) { __builtin_amdgcn_s_sleep(2);
        if ((++sp & 255u) == 0u) { if (__hip_atomic_load(tmo, __ATOMIC_RELAXED, __HIP_MEMORY_SCOPE_AGENT)) break; if (sp > (1u << 20)) { atomicAdd(tmo, 1u); break; } } }
      __builtin_amdgcn_fence(__ATOMIC_ACQUIRE, "agent");
      asm volatile("s_waitcnt vmcnt(0)" ::: "memory");
    }
    LAS float* biasS = (LAS float*)(lds + LDS_MISC + 1024); LAS float* pwS = (LAS float*)(lds + LDS_MISC + 2048);
    if (otid() < 256) { const int r = mt * 256 + otid(); const int pr = (r < ce) ? p.list[e * CAP + r] : -1; pairS[otid()] = pr; if (which) pwS[otid()] = pr >= 0 ? p.pw[pr] : 0.f; }
    else { const int c = otid() - 256;
      biasS[c] = which ? p.bd[e * 2048 + pn * 256 + c] : (c < 128 ? p.bg[e * 2048 + pn * 128 + c] : p.bu[e * 2048 + pn * 128 + c - 128]); }
    __syncthreads();
    unsigned ao[2][2];
#pragma unroll
    for (int h = 0; h < 2; ++h)
#pragma unroll
      for (int i = 0; i < 2; ++i) { int R, C; stage_rc(otid() * 16 + i * 8192, R, C); const int pr = pairS[h * 128 + R];
        ao[h][i] = pr < 0 ? 0x80000000u : (unsigned)((which ? pr : (pr >> 2)) * KDIM + C) * 2u; }
    const size_t eo = (size_t)e * 2048 * 2048;
    const bool half = (ce - mt * 256) <= 128;
    if (which == 0) { EpiAct E{mk_rsrc(p.act), biasS, pairS, pn};
      if (half) gemm_unit_f32b<true>(lds, mk_rsrc(p.tb), ao, mk_rsrc(p.wg + eo + pn * 128), mk_rsrc(p.wu + eo + pn * 128), E);
      else gemm_unit_f32b<false>(lds, mk_rsrc(p.tb), ao, mk_rsrc(p.wg + eo + pn * 128), mk_rsrc(p.wu + eo + pn * 128), E); }
    else { EpiY E{p.y, biasS, pwS, pairS, pn};
      if (half) gemm_unit_f32b<true>(lds, mk_rsrc(p.act), ao, mk_rsrc(p.wd + eo + pn * 256), mk_rsrc(p.wd + eo + pn * 256 + 128), E);
      else gemm_unit_f32b<false>(lds, mk_rsrc(p.act), ao, mk_rsrc(p.wd + eo + pn * 256), mk_rsrc(p.wd + eo + pn * 256 + 128), E); }
    if (which == 0) asm volatile("s_waitcnt vmcnt(0)" ::: "memory");
    __syncthreads();
    if (otid() == 0) { if (which == 0) __hip_atomic_fetch_add(dn, 1u, __ATOMIC_RELAXED, __HIP_MEMORY_SCOPE_AGENT); qS[0] = (int)nxt; }
    __syncthreads();
  }
}

__device__ __forceinline__ void ph_combine(const Params& p) {
  for (int g0 = blockIdx.x * 512 + otid(); g0 < T_TOK * 256; g0 += gridDim.x * 1024) {
    f32x4 a[2], b[2]; u32x4 av[2], y[2][4];
#pragma unroll
    for (int z = 0; z < 2; ++z) { int g = g0 + z * gridDim.x * 512; g = g < T_TOK * 256 ? g : g0; const size_t eo = (size_t)g * 8; const int t = g >> 8, c8 = (g & 255) * 8;
      a[z] = *(const f32x4*)(p.x + eo); b[z] = *(const f32x4*)(p.x + eo + 4); av[z] = *(const u32x4*)(p.hn + eo);
#pragma unroll
      for (int k = 0; k < 4; ++k) y[z][k] = *(const u32x4*)(p.y + (size_t)(t * 4 + k) * DM + c8); }
#pragma unroll
    for (int z = 0; z < 2; ++z) { int g = g0 + z * gridDim.x * 512; g = g < T_TOK * 256 ? g : g0; f32x4 aa = a[z], bb = b[z];
      aa[0] += bflo(av[z].x); aa[1] += bfhi(av[z].x); aa[2] += bflo(av[z].y); aa[3] += bfhi(av[z].y); bb[0] += bflo(av[z].z); bb[1] += bfhi(av[z].z); bb[2] += bflo(av[z].w); bb[3] += bfhi(av[z].w);
#pragma unroll
      for (int k = 0; k < 4; ++k) { const u32x4 yy = y[z][k];
        aa[0] += bflo(yy.x); aa[1] += bfhi(yy.x); aa[2] += bflo(yy.y); aa[3] += bfhi(yy.y); bb[0] += bflo(yy.z); bb[1] += bfhi(yy.z); bb[2] += bflo(yy.w); bb[3] += bfhi(yy.w); }
      float* op = p.out + (size_t)g * 8; *(f32x4*)op = aa; *(f32x4*)(op + 4) = bb; }
  }
}

template <int PH> __device__ __forceinline__ void run_phase(const Params& p, LAS char* lds) {
  if constexpr (PH == 0) { ph_norm_gd(p, lds); ph_convert(p, lds); }
  if constexpr (PH == 1) { ph_inproj(p, lds); ph_gdown(p, lds); }
  if constexpr (PH == 2) { ph_gla1(p, lds); if (PROBE & 128) ph_gla1(p, lds); }
  if constexpr (PH == 3) ph_gla_scan(p, lds);
  if constexpr (PH == 4) { ph_gla3(p, lds); if (PROBE & 256) ph_gla3(p, lds); ph_attn(p, lds); if (PROBE & 512) ph_attn(p, lds); }
  if constexpr (PH == 5) ph_outproj(p, lds);
  if constexpr (PH == 6) ph_router(p, lds);
  if constexpr (PH == 7) ph_moe_all(p, lds);
  if constexpr (PH == 9) ph_combine(p);
}
extern __shared__ __attribute__((aligned(16))) char smem_raw[];
#if !FUSED
template <int PH> __global__ void __launch_bounds__(512, 2) k_phase(Params p) {
  LAS char* lds = (LAS char*)smem_raw;
  run_phase<PH>(p, lds);
}
#else
typedef const __attribute__((address_space(4))) Params* KArgP;
__device__ __forceinline__ Params load_params(KArgP k) { Params q; q.x = k->x; q.attn_norm_w = k->attn_norm_w; q.w_in = k->w_in; q.q_norm_w = k->q_norm_w; q.k_norm_w = k->k_norm_w; q.lq1 = k->lq1; q.lk1 = k->lk1; q.lq2 = k->lq2; q.lk2 = k->lk2; q.subln_w = k->subln_w; q.gate_up_w = k->gate_up_w; q.gate_up_b = k->gate_up_b; q.gla_norm_w = k->gla_norm_w; q.w_out = k->w_out; q.ffn_norm_w = k->ffn_norm_w; q.router_w = k->router_w; q.router_b = k->router_b; q.wg = k->wg; q.bg = k->bg; q.wu = k->wu; q.bu = k->bu; q.wd = k->wd; q.bd = k->bd; q.out = k->out; q.bar = k->bar; q.cnt = k->cnt; q.wt_in = k->wt_in; q.wt_out = k->wt_out; q.wgd_hi = k->wgd_hi; q.wgd_lo = k->wgd_lo; q.hn = k->hn; q.proj = k->proj; q.mix = k->mix; q.qtil = k->qtil; q.st = k->st; q.tb = k->tb; q.wr_hi = k->wr_hi; q.wr_lo = k->wr_lo; q.act = k->act; q.y = k->y; q.gd = k->gd; q.decay = k->decay; q.pw = k->pw; q.oib = k->oib; q.Ub = k->Ub; q.list = k->list; return q; }
#define RUN(PHX) do { KArgP kp_ = kp0; asm volatile("" : "+s"(kp_)); const Params q_ = load_params(kp_); run_phase<PHX>(q_, lds); } while (0)
__global__ void __launch_bounds__(512, 2) k_fused(Params p) {
  LAS char* lds = (LAS char*)smem_raw;
  const KArgP kp0 = (KArgP)__builtin_amdgcn_kernarg_segment_ptr();
  volatile LAS unsigned* xbw = (volatile LAS unsigned*)(lds + LDS_BYTES - 16);
  if (threadIdx.x == 0) { xbw[0] = 0u; xbw[1] = 0u; xbw[2] = 0u; xbw[3] = 0u; }
  __syncthreads();
  XcdBarrier bar = xcd_barrier_post(p.bar, xbw);
#define DUP(PHX, MASK) if (PROBE & (MASK)) { RUN(PHX); xcd_barrier(bar); }
  RUN(0); xcd_barrier(bar); DUP(0, 1)
  RUN(1); xcd_barrier(bar); DUP(1, 2)
  RUN(2); xcd_barrier(bar);
  RUN(3); xcd_barrier(bar); DUP(3, 4)
  RUN(4); xcd_barrier(bar); DUP(4, 8)
  RUN(5); xcd_barrier(bar); DUP(5, 16)
  RUN(6); xcd_barrier(bar);
  RUN(7); xcd_barrier(bar);
  RUN(9);
#undef DUP
#undef RUN
}
#endif

static size_t carve(size_t& off, size_t bytes) { const size_t o = off; off = (off + bytes + 255) & ~(size_t)255; return o; }

#if !FUSED
template <int PH> static void launch_phase(const Params& p, int grid, hipStream_t s) {
  static bool set = false;
  if (!set) { (void)hipFuncSetAttribute((const void*)k_phase<PH>, hipFuncAttributeMaxDynamicSharedMemorySize, LDS_BYTES); set = true; }
  hipLaunchKernelGGL(k_phase<PH>, dim3(grid), dim3(512), LDS_BYTES, s, p);
}
#endif

extern "C" void kernel_launch(void* const* d_in, const int* in_sizes, int n_in, void* d_out, int out_size, void* d_ws, size_t ws_size, hipStream_t stream) {
  (void)in_sizes; (void)n_in; (void)out_size;
  Params p{};
  const float* const* in = (const float* const*)d_in;
  p.x = in[0]; p.attn_norm_w = in[1]; p.w_in = in[2]; p.q_norm_w = in[3]; p.k_norm_w = in[4]; p.lq1 = in[5]; p.lk1 = in[6]; p.lq2 = in[7]; p.lk2 = in[8];
  p.subln_w = in[9]; p.gate_up_w = in[10]; p.gate_up_b = in[11]; p.gla_norm_w = in[12]; p.w_out = in[13]; p.ffn_norm_w = in[14]; p.router_w = in[15]; p.router_b = in[16];
  p.wg = in[17]; p.bg = in[18]; p.wu = in[19]; p.bu = in[20]; p.wd = in[21]; p.bd = in[22];
  p.out = (float*)d_out;
  char* ws = (char*)d_ws; size_t off = 0;
  const size_t ctl = carve(off, CTL_BYTES);
  p.bar = (unsigned*)(ws + ctl); p.cnt = p.bar + CW_CNT;
  const size_t WSZ = (size_t)2048 * 2048 * 2;
  p.wt_in = (bf16_t*)(ws + carve(off, (size_t)NP * 2048 * 2));
  p.wt_out = (bf16_t*)(ws + carve(off, WSZ));
  p.wgd_hi = (bf16_t*)(ws + carve(off, 16 * 2048 * 2)); p.wgd_lo = (bf16_t*)(ws + carve(off, 16 * 2048 * 2));
  p.hn = (bf16_t*)(ws + carve(off, (size_t)T_TOK * DM * 2));
  p.proj = (bf16_t*)(ws + carve(off, (size_t)T_TOK * NP * 2));
  p.mix = (bf16_t*)(ws + carve(off, (size_t)T_TOK * DM * 2));
  p.qtil = (bf16_t*)(ws + carve(off, (size_t)512 * 64 * 128 * 2));
  p.st = (bf16_t*)(ws + carve(off, (size_t)512 * 256 * 128 * 2));
  p.tb = (bf16_t*)(ws + carve(off, (size_t)T_TOK * DM * 2));
  p.wr_hi = (bf16_t*)(ws + carve(off, 32 * 2048 * 2)); p.wr_lo = (bf16_t*)(ws + carve(off, 32 * 2048 * 2));
  p.act = (bf16_t*)(ws + carve(off, (size_t)T_TOK * 4 * DM * 2));
  p.y = (bf16_t*)(ws + carve(off, (size_t)T_TOK * 4 * DM * 2));
  p.gd = (float*)(ws + carve(off, (size_t)T_TOK * 16 * 4));
  p.oib = (bf16_t*)(ws + carve(off, (size_t)512 * 64 * 256 * 2));
  p.Ub = (bf16_t*)(ws + carve(off, (size_t)512 * 256 * 128 * 2));
  p.decay = (float*)(ws + carve(off, 512 * 128 * 4));
  p.pw = (float*)(ws + carve(off, (size_t)T_TOK * 4 * 4));
  p.list = (int*)(ws + carve(off, (size_t)NEXP * CAP * 4));
  if (off > ws_size) { fprintf(stderr, "kernel_launch: workspace too small: need %zu have %zu\n", off, ws_size); return; }
  static int grid = 0;
  if (!grid) { int dev = 0, cus = 0; (void)hipGetDevice(&dev); (void)hipDeviceGetAttribute(&cus, hipDeviceAttributeMultiprocessorCount, dev); grid = cus > 0 ? cus : 256; }
  (void)hipMemsetAsync(ws + ctl, 0, CTL_BYTES, stream);
#if !FUSED
  launch_phase<0>(p, grid, stream); launch_phase<1>(p, grid, stream); launch_phase<2>(p, grid, stream); launch_phase<3>(p, grid, stream); launch_phase<4>(p, grid, stream);
  launch_phase<5>(p, grid, stream); launch_phase<6>(p, grid, stream); launch_phase<7>(p, grid, stream); launch_phase<8>(p, grid, stream); launch_phase<9>(p, grid, stream);
#else
  static bool set = false;
  if (!set) {
    (void)hipFuncSetAttribute((const void*)k_fused, hipFuncAttributeMaxDynamicSharedMemorySize, LDS_BYTES);
    int per_cu = 0;
    if (hipOccupancyMaxActiveBlocksPerMultiprocessor(&per_cu, (const void*)k_fused, 512, LDS_BYTES) != hipSuccess || per_cu < 1)
      fprintf(stderr, "kernel_launch: occupancy query reports %d workgroups per CU\n", per_cu);
    set = true;
  }
  hipLaunchKernelGGL(k_fused, dim3(grid), dim3(512), LDS_BYTES, stream, p);
#endif
  const hipError_t le = hipPeekAtLastError();
  if (le != hipSuccess) fprintf(stderr, "kernel_launch: launch failed: %s\n", hipGetErrorName(le));
}
```

```cpp
#include <hip/hip_runtime.h>
#include <stdint.h>
#include <stdio.h>

#ifndef FUSED
#define FUSED 1
#endif
#define PROBE 0

#define LAS __attribute__((address_space(3)))
typedef unsigned short bf16_t;
typedef short bf16x8 __attribute__((ext_vector_type(8)));
typedef short s16x4 __attribute__((ext_vector_type(4)));
typedef float f32x4 __attribute__((ext_vector_type(4)));
typedef float f32x16 __attribute__((ext_vector_type(16)));
typedef unsigned u32x4 __attribute__((ext_vector_type(4)));
typedef unsigned u32x2 __attribute__((ext_vector_type(2)));

constexpr int T_TOK = 8192, DM = 2048, NP = 6144, LDW = 6160, SEQ = 2048;
constexpr int NEXP = 32, CAP = 8192;
constexpr int LDS_BYTES = 147456;
constexpr int LDS_PAIR = 131072;
constexpr int LDS_MISC = 131072 + 1024;
constexpr int CW_CNT = 3456, CW_QHEAD = 3520, CW_TMO = 3712, CW_DONE = 4096;
constexpr int CTL_BYTES = (4096 + 32 * 32 * 16) * 4;

__device__ __forceinline__ unsigned cvt_pk_bf16(float lo, float hi) { unsigned r; asm("v_cvt_pk_bf16_f32 %0, %1, %2" : "=v"(r) : "v"(lo), "v"(hi)); return r; }
__device__ __forceinline__ float bf2f(bf16_t b) { return __uint_as_float(((unsigned)b) << 16); }
__device__ __forceinline__ float bflo(unsigned w) { return __uint_as_float(w << 16); }
__device__ __forceinline__ float bfhi(unsigned w) { return __uint_as_float(w & 0xffff0000u); }
__device__ __forceinline__ bf16_t f2bf(float f) { return (bf16_t)(cvt_pk_bf16(f, 0.f) & 0xffffu); }
__device__ __forceinline__ float wave_sum(float v) {
#pragma unroll
  for (int o = 32; o >= 1; o >>= 1) v += __shfl_xor(v, o);
  return v;
}

typedef __bf16 cbf2 __attribute__((ext_vector_type(2)));
typedef float cf2 __attribute__((ext_vector_type(2)));
__device__ __forceinline__ unsigned pkc(float a, float b) { cf2 v = {a, b}; cbf2 r = __builtin_convertvector(v, cbf2); return *reinterpret_cast<unsigned*>(&r); }
__device__ __forceinline__ void quad_pair16(const u32x2 w0, const u32x2 w1, const int odd, u32x4& out) {
  const unsigned sx = odd ? w0.x : w1.x, sy = odd ? w0.y : w1.y;
  const unsigned rx = (unsigned)__shfl_xor((int)sx, 16), ry = (unsigned)__shfl_xor((int)sy, 16);
  out = odd ? (u32x4){rx, ry, w1.x, w1.y} : (u32x4){w0.x, w0.y, rx, ry};
}
__device__ __forceinline__ int otid() { int t = threadIdx.x; asm volatile("" : "+v"(t)); return t; }
#define XB_TMO      128
#define XB_XCNT(j)  (256  + 64 * (j))
#define XB_XSUB(j)  (1280 + 64 * (j))
#define XB_XGEN(j)  (2304 + 64 * (j))
#define XB_TOP      3328
#define XB_TOPGEN   3392
#define XCD_BAR_WORDS 3456
#define XB_SPIN_CAP (1u << 18)
__device__ __forceinline__ unsigned xb_ld(unsigned* p)              { return __hip_atomic_load(p, __ATOMIC_RELAXED, __HIP_MEMORY_SCOPE_AGENT); }
__device__ __forceinline__ unsigned xb_add(unsigned* p, unsigned v) { return __hip_atomic_fetch_add(p, v, __ATOMIC_RELAXED, __HIP_MEMORY_SCOPE_AGENT); }
__device__ __forceinline__ unsigned xb_xcc_id() { return (unsigned)__builtin_amdgcn_s_getreg((3 << 11) | 20) & 0xFu; }
#define XB_SPIN(cond, bar) do { unsigned _sp = 0; while (cond) { __builtin_amdgcn_s_sleep(1); \
    if ((++_sp & 255u) == 0u) { if (xb_ld(&(bar)[XB_TMO])) break; if (_sp > XB_SPIN_CAP) { atomicAdd(&(bar)[XB_TMO], 1u); break; } } } } while (0)
struct XcdBarrier { unsigned* bar; unsigned x; volatile LAS unsigned* st; };
__device__ __forceinline__ XcdBarrier xcd_barrier_post(unsigned* bar, volatile LAS unsigned* st) {
    XcdBarrier b; b.bar = bar; b.x = xb_xcc_id(); b.st = st;
    if (threadIdx.x == 0) (void)xb_add(&bar[XB_XCNT(b.x)], 1u);
    return b;
}
__device__ __forceinline__ void xcd_barrier_complete(unsigned* bar, unsigned x, unsigned& nloc, unsigned& nx) {
    const unsigned G = gridDim.x * gridDim.y * gridDim.z;
    unsigned sum, cnt, mine, sp = 0u;
    for (;;) {
        sum = 0u; cnt = 0u; mine = 0u;
#pragma unroll
        for (unsigned j = 0; j < 16; ++j) { const unsigned c = xb_ld(&bar[XB_XCNT(j)]); sum += c; cnt += (c > 0u) ? 1u : 0u; mine = (j == x) ? c : mine; }
        if (sum == G) break;
        __builtin_amdgcn_s_sleep(1);
        if ((++sp & 255u) == 0u) { if (xb_ld(&bar[XB_TMO])) break; if (sp > XB_SPIN_CAP) { atomicAdd(&bar[XB_TMO], 1u); break; } }
    }
    nloc = mine > 0u ? mine : 1u; nx = cnt > 0u ? cnt : 1u;
}
__device__ __forceinline__ void xcd_barrier(const XcdBarrier& b) {
    asm volatile("s_waitcnt vmcnt(0)" ::: "memory");
    __syncthreads();
    if (threadIdx.x == 0) {
        unsigned* bar = b.bar;
        __builtin_amdgcn_s_waitcnt(0);
        unsigned nloc = b.st[0], nx = b.st[1];
        if (nloc == 0u) { xcd_barrier_complete(bar, b.x, nloc, nx); b.st[0] = nloc; b.st[1] = nx; }
        const unsigned old = xb_add(&bar[XB_XSUB(b.x)], 1u);
        const unsigned gen = old / nloc;
        if (old + 1u == (gen + 1u) * nloc) {
            __builtin_amdgcn_fence(__ATOMIC_RELEASE, "agent");
            asm volatile("s_waitcnt vmcnt(0)" ::: "memory");
            const unsigned og = xb_add(&bar[XB_TOP], 1u);
            const unsigned tg = og / nx;
            if (og + 1u == (tg + 1u) * nx) xb_add(&bar[XB_TOPGEN], 1u);
            else XB_SPIN(xb_ld(&bar[XB_TOPGEN]) == tg, bar);
            __builtin_amdgcn_fence(__ATOMIC_ACQUIRE, "agent");
            xb_add(&bar[XB_XGEN(b.x)], 1u);
            asm volatile("s_waitcnt vmcnt(0)" ::: "memory");
        } else {
            XB_SPIN(xb_ld(&bar[XB_XGEN(b.x)]) == gen, bar);
            __builtin_amdgcn_fence(__ATOMIC_ACQUIRE, "agent");
            asm volatile("s_waitcnt vmcnt(0)" ::: "memory");
        }
    }
    __syncthreads();
}

struct Params {
  const float *x, *attn_norm_w, *w_in, *q_norm_w, *k_norm_w, *lq1, *lk1, *lq2, *lk2, *subln_w, *gate_up_w, *gate_up_b, *gla_norm_w,
              *w_out, *ffn_norm_w, *router_w, *router_b, *wg, *bg, *wu, *bu, *wd, *bd;
  float* out;
  unsigned* bar; unsigned* cnt;
  bf16_t *wt_in, *wt_out, *wgd_hi, *wgd_lo, *hn, *proj, *mix, *qtil, *st, *tb, *wr_hi, *wr_lo, *act, *y;
  float *gd, *decay, *pw; bf16_t *oib, *Ub;
  int* list;
};

constexpr int BM = 256, BK = 64, HALF = 128, HTB = HALF * BK * 2, KDIM = 2048, NKT = KDIM / BK;
__device__ __forceinline__ int lds_byte(int r, int c) { const int st = (r >> 4) * 2 + (c >> 5), rr = r & 15, cc = c & 31, ob = rr * 64 + cc * 2; return st * 1024 + (ob ^ (((ob >> 9) & 1) << 5)); }
__device__ __forceinline__ void stage_rc(int b, int& R, int& C) { const int st = b / 1024, sb = b % 1024, swz = sb ^ (((sb >> 9) & 1) << 5); R = (st >> 1) * 16 + swz / 64; C = (st & 1) * 32 + (swz % 64) / 2; }
__device__ __forceinline__ int perm32(int rho) { const int n = rho >> 4, i = rho & 15; return 8 * (i >> 2) + 4 * n + (i & 3); }

typedef __amdgpu_buffer_rsrc_t rsrc_t;
__device__ __forceinline__ rsrc_t mk_rsrc(const void* p) { return __builtin_amdgcn_make_buffer_rsrc((void*)p, 0, 0x7fffffff, 0x00020000); }
__device__ __forceinline__ void bglds16(rsrc_t r, unsigned voff, unsigned soff, LAS char* l) { __builtin_amdgcn_raw_ptr_buffer_load_lds(r, (LAS unsigned*)l, 16, (int)voff, (int)soff, 0, 0); }

template <class Epi>
__device__ __forceinline__ void gemm_unit(LAS char* lds, const rsrc_t RA, const unsigned (&ao)[2][2], const rsrc_t RB0, const rsrc_t RB1, const unsigned (&bo)[2], const Epi& E,
                                          const int pre = 0, const int nx = 0, const rsrc_t RB0n = rsrc_t(), const rsrc_t RB1n = rsrc_t(), const unsigned (&bon)[2] = {0u, 0u}) {
  const int tid = otid(), wid = __builtin_amdgcn_readfirstlane(tid >> 6), lane = tid & 63, wr = wid >> 2, wc = wid & 3, fr = lane & 15, fq = lane >> 4;
  const unsigned ldsw = (unsigned)wid * 1024u;
  const int aoff = lds_byte(wr * 64 + fr, fq * 8), boff = lds_byte(wc * 32 + fr, fq * 8);
#define G_SA(b, h) (((b) * 2 + (h)) * HTB)
#define G_SB(b, h) ((4 + (b) * 2 + (h)) * HTB)
#define G_STAGE_A(b, h, kt) do { const unsigned _so = (unsigned)(kt) * (BK * 2); bglds16(RA, ao[h][0], _so, lds + G_SA(b, h) + ldsw); bglds16(RA, ao[h][1], _so, lds + G_SA(b, h) + ldsw + 8192); } while (0)
#define G_STAGE_B(b, h, kt) do { const unsigned _so = (unsigned)(kt) * (BK * 2); bglds16((h) ? RB1 : RB0, bo[0], _so, lds + G_SB(b, h) + ldsw); bglds16((h) ? RB1 : RB0, bo[1], _so, lds + G_SB(b, h) + ldsw + 8192); } while (0)
#define G_LDA(dst, b, h) do { _Pragma("unroll") for (int m = 0; m < 4; ++m) _Pragma("unroll") for (int k = 0; k < 2; ++k) dst[m][k] = *(const LAS bf16x8*)(lds + G_SA(b, h) + aoff + m * 2048 + k * 1024); } while (0)
#define G_LDB(dst, b, h) do { _Pragma("unroll") for (int n = 0; n < 2; ++n) _Pragma("unroll") for (int k = 0; k < 2; ++k) dst[n][k] = *(const LAS bf16x8*)(lds + G_SB(b, h) + boff + n * 2048 + k * 1024); } while (0)
#define G_MMA(ai, bj, At, Bt) do { __builtin_amdgcn_s_setprio(1); _Pragma("unroll") for (int m = 0; m < 4; ++m) _Pragma("unroll") for (int n = 0; n < 2; ++n) _Pragma("unroll") for (int k = 0; k < 2; ++k) \
    acc[ai][bj][m][n] = __builtin_amdgcn_mfma_f32_16x16x32_bf16(Bt[n][k], At[m][k], acc[ai][bj][m][n], 0, 0, 0); __builtin_amdgcn_s_setprio(0); } while (0)
#define G_WV(n) asm volatile("s_waitcnt vmcnt(" #n ")" ::: "memory")
#define G_WL(n) asm volatile("s_waitcnt lgkmcnt(" #n ")" ::: "memory")
#define G_BAR __builtin_amdgcn_s_barrier()
#define G_SCHED __builtin_amdgcn_sched_barrier(0)
  f32x4 acc[2][2][4][2];
#pragma unroll
  for (int a = 0; a < 2; ++a)
#pragma unroll
    for (int b = 0; b < 2; ++b)
#pragma unroll
      for (int m = 0; m < 4; ++m)
#pragma unroll
        for (int n = 0; n < 2; ++n) acc[a][b][m][n] = (f32x4){0.f, 0.f, 0.f, 0.f};
  bf16x8 At[4][2], Bq0[2][2], Bq1[2][2];
  if (!pre) { G_STAGE_B(0, 0, 0); G_STAGE_A(0, 0, 0); G_STAGE_B(0, 1, 0); G_STAGE_A(0, 1, 0); }
  if (wr == 1) G_BAR;
  G_WV(4); G_BAR;
  G_STAGE_B(1, 0, 1); G_STAGE_A(1, 0, 1); G_STAGE_B(1, 1, 1);
  G_WV(6); G_BAR;
  for (int t = 0; t < NKT - 2; t += 2) {
    G_LDB(Bq0, 0, 0); G_SCHED; G_LDA(At, 0, 0); G_STAGE_A(1, 1, t + 1);
    G_WL(8); G_BAR; G_WL(0); G_MMA(0, 0, At, Bq0); G_BAR; G_SCHED;
    G_LDB(Bq1, 0, 1); G_STAGE_B(0, 0, t + 2);
    G_BAR; G_WL(0); G_MMA(0, 1, At, Bq1); G_BAR;
    G_LDA(At, 0, 1); G_STAGE_A(0, 0, t + 2);
    G_BAR; G_WL(0); G_MMA(1, 0, At, Bq0); G_BAR; G_SCHED;
    G_STAGE_B(0, 1, t + 2);
    G_WV(6); G_BAR; G_MMA(1, 1, At, Bq1); G_BAR;
    G_LDB(Bq0, 1, 0); G_SCHED; G_LDA(At, 1, 0); G_STAGE_A(0, 1, t + 2);
    G_WL(8); G_BAR; G_WL(0); G_MMA(0, 0, At, Bq0); G_BAR; G_SCHED;
    G_LDB(Bq1, 1, 1); G_STAGE_B(1, 0, t + 3);
    G_BAR; G_WL(0); G_MMA(0, 1, At, Bq1); G_BAR;
    G_LDA(At, 1, 1); G_STAGE_A(1, 0, t + 3);
    G_BAR; G_WL(0); G_MMA(1, 0, At, Bq0); G_BAR; G_SCHED;
    G_STAGE_B(1, 1, t + 3);
    G_WV(6); G_BAR; G_MMA(1, 1, At, Bq1); G_BAR;
  }
  { G_LDB(Bq0, 0, 0); G_LDA(At, 0, 0); G_STAGE_A(1, 1, NKT - 1);
    G_BAR; G_WL(0); G_MMA(0, 0, At, Bq0); G_BAR;
    G_LDB(Bq1, 0, 1); G_BAR; G_WL(0); G_MMA(0, 1, At, Bq1); G_BAR;
    G_LDA(At, 0, 1); G_WV(4); G_BAR; G_WL(0); G_MMA(1, 0, At, Bq0); G_MMA(1, 1, At, Bq1); G_BAR; }
  { G_LDB(Bq0, 1, 0); G_LDA(At, 1, 0); G_WV(2); G_BAR; G_WL(0); G_MMA(0, 0, At, Bq0); G_BAR;
    G_LDB(Bq1, 1, 1); G_WV(0); G_BAR; G_WL(0); G_MMA(0, 1, At, Bq1); G_BAR;
    G_LDA(At, 1, 1); G_BAR; G_WL(0); G_MMA(1, 0, At, Bq0); G_MMA(1, 1, At, Bq1); G_BAR; }
  if (wr == 0) G_BAR;
  if (nx) {
    bglds16(RB0n, bon[0], 0u, lds + G_SB(0, 0) + ldsw); bglds16(RB0n, bon[1], 0u, lds + G_SB(0, 0) + ldsw + 8192); G_STAGE_A(0, 0, 0);
    bglds16(RB1n, bon[0], 0u, lds + G_SB(0, 1) + ldsw); bglds16(RB1n, bon[1], 0u, lds + G_SB(0, 1) + ldsw + 8192); G_STAGE_A(0, 1, 0); }
  { int tz = otid(); asm volatile("" : "+v"(tz)); const int wid2 = tz >> 6, lane2 = tz & 63; E(acc, wid2 >> 2, wid2 & 3, lane2 & 15, lane2 >> 4); }
#undef G_SA
#undef G_SB
#undef G_STAGE_A
#undef G_STAGE_B
#undef G_LDA
#undef G_LDB
#undef G_MMA
#undef G_WV
#undef G_WL
#undef G_BAR
#undef G_SCHED
}


__device__ __forceinline__ u32x4 bl_asm0(unsigned voff, rsrc_t r, unsigned soff) { u32x4 x; asm volatile("s_nop 4\n\tbuffer_load_dwordx4 %0, %1, %2, %3 offen" : "=v"(x) : "v"(voff), "s"(r), "s"(soff) : "memory"); return x; }
__device__ __forceinline__ u32x4 bl_asm1(unsigned voff, rsrc_t r, unsigned soff) { u32x4 x; asm volatile("buffer_load_dwordx4 %0, %1, %2, %3 offen" : "=v"(x) : "v"(voff), "s"(r), "s"(soff) : "memory"); return x; }
template <int OFF> __device__ __forceinline__ s16x4 trb(int vb) { s16x4 r; asm volatile("ds_read_b64_tr_b16 %0, %1 offset:%2" : "=v"(r) : "v"(vb), "i"(OFF) : "memory"); return r; }
template <bool HALF, class Epi>
__device__ __forceinline__ void gemm_unit_f32b(LAS char* lds, const rsrc_t RA, const unsigned (&ao)[2][2], const rsrc_t RB0, const rsrc_t RB1, const Epi& E) {
  const int tid = otid(), wid = __builtin_amdgcn_readfirstlane(tid >> 6), lane = tid & 63, wr = wid >> 2, wc = wid & 3, fr = lane & 15, fq = lane >> 4;
  const unsigned ldsw = (unsigned)wid * 1024u;
  const int aoff = lds_byte(wr * 64 + fr, fq * 8);
  constexpr int BREG = 65536;
  const int ldsb = (int)(unsigned)(uintptr_t)lds;
  const int q4 = fr >> 2, pp = lane & 3, frd = q4 | ((fq & 1) << 2);
  const int kb = ldsb + BREG + (8 * fq + q4) * 512 + pp * 8;
  const int brd0 = kb + (((2 * wc + 0) ^ frd) << 5), brd1 = kb + (((2 * wc + 1) ^ frd) << 5);
  const int n4 = lane & 31, hiw = lane >> 5, fwx = hiw | ((wid & 1) << 2), fwy = fwx ^ 2;
  LAS char* bwx = lds + BREG + (8 * wid + hiw) * 512 + (((n4 >> 2) ^ fwx) << 5) + (n4 & 3) * 8;
  LAS char* bwy = lds + BREG + (8 * wid + hiw + 2) * 512 + (((n4 >> 2) ^ fwy) << 5) + (n4 & 3) * 8;
  const unsigned bvoff = (unsigned)(hiw * 8192 + n4 * 16);
  const unsigned bsw = (unsigned)wid * 65536u;
#define F_SA(b, h) (((b) * 2 + (h)) * HTB)
#define F_STAGE_A(b, h, kt) do { const unsigned _so = (unsigned)(kt) * (BK * 2); bglds16(RA, ao[h][0], _so, lds + F_SA(b, h) + ldsw); bglds16(RA, ao[h][1], _so, lds + F_SA(b, h) + ldsw + 8192); } while (0)
#define F_LDA(dst, b, h) do { _Pragma("unroll") for (int m = 0; m < 4; ++m) _Pragma("unroll") for (int k = 0; k < 2; ++k) dst[m][k] = *(const LAS bf16x8*)(lds + F_SA(b, h) + aoff + m * 2048 + k * 1024); } while (0)
#define F_TR1(dst, base, b, ks, bj) do { const s16x4 _l = trb<(b) * 32768 + (ks) * 16384 + (bj) * 256>(base), _h = trb<(b) * 32768 + (ks) * 16384 + 2048 + (bj) * 256>(base); \
    dst = (bf16x8){_l[0], _l[1], _l[2], _l[3], _h[0], _h[1], _h[2], _h[3]}; } while (0)
#define F_LDB(dst, b, bj) do { F_TR1(dst[0][0], brd0, b, 0, bj); F_TR1(dst[0][1], brd0, b, 1, bj); F_TR1(dst[1][0], brd1, b, 0, bj); F_TR1(dst[1][1], brd1, b, 1, bj); } while (0)
#define F_MMA(ai, bj, At, Bt) do { __builtin_amdgcn_s_setprio(1); _Pragma("unroll") for (int m = 0; m < 4; ++m) _Pragma("unroll") for (int n = 0; n < 2; ++n) _Pragma("unroll") for (int k = 0; k < 2; ++k) \
    acc[ai][bj][m][n] = __builtin_amdgcn_mfma_f32_16x16x32_bf16(Bt[n][k], At[m][k], acc[ai][bj][m][n], 0, 0, 0); __builtin_amdgcn_s_setprio(0); } while (0)
#define F_BLOAD(SX, SY, kt, i) do { const unsigned _so = (unsigned)(kt) * 524288u + bsw + (unsigned)((i) >> 1) * 32768u; \
    const unsigned _so2 = _so + 16384u; if ((i) & 1) { SX = bl_asm1(bvoff, RB1, _so); SY = bl_asm1(bvoff, RB1, _so2); } else { SX = bl_asm1(bvoff, RB0, _so); SY = bl_asm1(bvoff, RB0, _so2); } } while (0)
#define F_BLOAD_FIRST(SX, SY) do { SX = bl_asm0(bvoff, RB0, bsw); SY = bl_asm1(bvoff, RB0, bsw + 16384u); } while (0)
#define F_BWAIT(SX, SY, n) asm volatile("s_waitcnt vmcnt(" #n ")" : "+v"(SX), "+v"(SY) :: "memory")
#define F_BWRITE(SX, SY, b, i) do { u32x2 _wx, _wy; _wx.x = cvt_pk_bf16(__uint_as_float(SX.x), __uint_as_float(SX.y)); _wx.y = cvt_pk_bf16(__uint_as_float(SX.z), __uint_as_float(SX.w)); \
    _wy.x = cvt_pk_bf16(__uint_as_float(SY.x), __uint_as_float(SY.y)); _wy.y = cvt_pk_bf16(__uint_as_float(SY.z), __uint_as_float(SY.w)); \
    *(LAS u32x2*)(bwx + (b) * 32768 + ((i) >> 1) * 2048 + ((i) & 1) * 256) = _wx; *(LAS u32x2*)(bwy + (b) * 32768 + ((i) >> 1) * 2048 + ((i) & 1) * 256) = _wy; } while (0)
#define F_BWAITH(SX, SY, nfull, nhalf) do { if constexpr (HALF) { F_BWAIT(SX, SY, nhalf); } else { F_BWAIT(SX, SY, nfull); } } while (0)
#define F_WL(n) asm volatile("s_waitcnt lgkmcnt(" #n ")" ::: "memory")
#define F_BAR __builtin_amdgcn_s_barrier()
#define F_SCHED __builtin_amdgcn_sched_barrier(0)
  f32x4 acc[2][2][4][2];
  E.init(acc, wc, fq);
  bf16x8 At[4][2], Bq0[2][2], Bq1[2][2];
  u32x4 Ex, Ey, Ox, Oy;
  F_STAGE_A(0, 0, 0); if constexpr (!HALF) F_STAGE_A(0, 1, 0); F_STAGE_A(1, 0, 1);
  { u32x4 P0x, P0y, P1x, P1y, P2x, P2y, P3x, P3y, P4x, P4y;
    F_BLOAD_FIRST(P0x, P0y); F_BLOAD(P1x, P1y, 0, 1); F_BLOAD(P2x, P2y, 0, 2); F_BLOAD(P3x, P3y, 0, 3); F_BLOAD(P4x, P4y, 1, 0);
    F_BLOAD(Ox, Oy, 1, 1); F_BLOAD(Ex, Ey, 1, 2);
    F_BWAIT(P0x, P0y, 12); F_BWRITE(P0x, P0y, 0, 0);
    F_BWAIT(P1x, P1y, 10); F_BWRITE(P1x, P1y, 0, 1);
    F_BWAIT(P2x, P2y, 8); F_BWRITE(P2x, P2y, 0, 2);
    F_BWAIT(P3x, P3y, 6); F_BWRITE(P3x, P3y, 0, 3);
    F_BWAIT(P4x, P4y, 4); F_BWRITE(P4x, P4y, 1, 0); }
  F_WL(0);
  if (wr == 1) F_BAR;
  F_BAR;
  for (int t = 0; t < NKT - 2; t += 2) {
    const int t2 = t + 2, t3 = t + 3;
    F_LDB(Bq0, 0, 0); F_LDA(At, 0, 0); if constexpr (!HALF) F_STAGE_A(1, 1, t + 1);
    F_BWAITH(Ox, Oy, 4, 2); F_BWRITE(Ox, Oy, 1, 1); F_BLOAD(Ox, Oy, t + 1, 3);
    F_BAR; F_WL(0); F_SCHED; F_MMA(0, 0, At, Bq0); F_BAR; F_SCHED;
    F_LDB(Bq1, 0, 1);
    F_BWAITH(Ex, Ey, 4, 2); F_BWRITE(Ex, Ey, 1, 2); F_BLOAD(Ex, Ey, t2, 0);
    F_BAR; F_WL(0); F_SCHED; F_MMA(0, 1, At, Bq1); F_BAR; F_SCHED;
    if constexpr (!HALF) F_LDA(At, 0, 1); F_STAGE_A(0, 0, t2);
    F_BWAIT(Ox, Oy, 4); F_BWRITE(Ox, Oy, 1, 3); F_BLOAD(Ox, Oy, t2, 1);
    F_BAR; F_WL(0); F_SCHED; if constexpr (!HALF) F_MMA(1, 0, At, Bq0); F_BAR; F_SCHED;
    F_BWAIT(Ex, Ey, 4); F_BWRITE(Ex, Ey, 0, 0); F_BLOAD(Ex, Ey, t2, 2);
    F_BAR; F_WL(0); F_SCHED; if constexpr (!HALF) F_MMA(1, 1, At, Bq1); F_BAR; F_SCHED;
    F_LDB(Bq0, 1, 0); F_LDA(At, 1, 0); if constexpr (!HALF) F_STAGE_A(0, 1, t2);
    F_BWAITH(Ox, Oy, 4, 2); F_BWRITE(Ox, Oy, 0, 1); F_BLOAD(Ox, Oy, t2, 3);
    F_BAR; F_WL(0); F_SCHED; F_MMA(0, 0, At, Bq0); F_BAR; F_SCHED;
    F_LDB(Bq1, 1, 1);
    F_BWAITH(Ex, Ey, 4, 2); F_BWRITE(Ex, Ey, 0, 2); F_BLOAD(Ex, Ey, t3, 0);
    F_BAR; F_WL(0); F_SCHED; F_MMA(0, 1, At, Bq1); F_BAR; F_SCHED;
    if constexpr (!HALF) F_LDA(At, 1, 1); F_STAGE_A(1, 0, t3);
    F_BWAIT(Ox, Oy, 4); F_BWRITE(Ox, Oy, 0, 3); F_BLOAD(Ox, Oy, t3, 1);
    F_BAR; F_WL(0); F_SCHED; if constexpr (!HALF) F_MMA(1, 0, At, Bq0); F_BAR; F_SCHED;
    F_BWAIT(Ex, Ey, 4); F_BWRITE(Ex, Ey, 1, 0); F_BLOAD(Ex, Ey, t3, 2);
    F_BAR; F_WL(0); F_SCHED; if constexpr (!HALF) F_MMA(1, 1, At, Bq1); F_BAR; F_SCHED;
  }
  {
    F_LDB(Bq0, 0, 0); F_LDA(At, 0, 0); if constexpr (!HALF) F_STAGE_A(1, 1, NKT - 1);
    F_BWAITH(Ox, Oy, 4, 2); F_BWRITE(Ox, Oy, 1, 1); F_BLOAD(Ox, Oy, NKT - 1, 3);
    F_BAR; F_WL(0); F_SCHED; F_MMA(0, 0, At, Bq0); F_BAR; F_SCHED;
    F_LDB(Bq1, 0, 1);
    F_BWAITH(Ex, Ey, 4, 2); F_BWRITE(Ex, Ey, 1, 2);
    F_BAR; F_WL(0); F_SCHED; F_MMA(0, 1, At, Bq1); F_BAR; F_SCHED;
    if constexpr (!HALF) F_LDA(At, 0, 1);
    F_BWAIT(Ox, Oy, 0); F_BWRITE(Ox, Oy, 1, 3);
    F_BAR; F_WL(0); F_SCHED; if constexpr (!HALF) F_MMA(1, 0, At, Bq0); F_BAR; F_SCHED;
    F_BAR; F_SCHED; if constexpr (!HALF) F_MMA(1, 1, At, Bq1); F_BAR; F_SCHED;
    F_LDB(Bq0, 1, 0); F_LDA(At, 1, 0);
    F_BAR; F_WL(0); F_SCHED; F_MMA(0, 0, At, Bq0); F_BAR; F_SCHED;
    F_LDB(Bq1, 1, 1);
    F_BAR; F_WL(0); F_SCHED; F_MMA(0, 1, At, Bq1); F_BAR; F_SCHED;
    if constexpr (!HALF) F_LDA(At, 1, 1);
    E.template part<0, 0, 2>(acc, wr, wc, fr, fq);
    F_BAR; F_WL(0); F_SCHED; if constexpr (!HALF) F_MMA(1, 0, At, Bq0); F_BAR; F_SCHED;
    E.template part<0, 2, 4>(acc, wr, wc, fr, fq);
    F_BAR; F_SCHED; if constexpr (!HALF) F_MMA(1, 1, At, Bq1); F_BAR; F_SCHED;
  }
  if (wr == 0) F_BAR;
  if constexpr (!HALF) { int tz = threadIdx.x; asm volatile("" : "+v"(tz)); const int wid2 = tz >> 6, lane2 = tz & 63; E.template part<1, 0, 4>(acc, wid2 >> 2, wid2 & 3, lane2 & 15, lane2 >> 4); }
#undef F_SA
#undef F_STAGE_A
#undef F_LDA
#undef F_TR1
#undef F_LDB
#undef F_MMA
#undef F_BLOAD
#undef F_BLOAD_FIRST
#undef F_BWAIT
#undef F_BWAITH
#undef F_BWRITE
#undef F_WL
#undef F_BAR
#undef F_SCHED
}

template <bool PERM> __device__ __forceinline__ void b_offsets(unsigned (&bo)[2]) {
#pragma unroll
  for (int i = 0; i < 2; ++i) { int R, C; stage_rc(otid() * 16 + i * 8192, R, C); const int Rb = PERM ? ((R & ~31) + perm32(R & 31)) : R; bo[i] = (unsigned)(Rb * KDIM + C) * 2u; }
}

__device__ __forceinline__ void ph_norm_gd(const Params& p, LAS char* lds) {
  const int tid = otid(), wid = tid >> 6, lane = tid & 63;
  f32x4 nw[8];
#pragma unroll
  for (int i = 0; i < 8; ++i) nw[i] = *(const f32x4*)(p.attn_norm_w + (i >> 1) * 512 + lane * 8 + (i & 1) * 4);
  for (int row = (blockIdx.x * 8 + wid) * 2; row < T_TOK; row += gridDim.x * 16) {
    const float* xr = p.x + (size_t)row * DM;
    f32x4 v[8], w2[8]; float ss = 0.f, s2 = 0.f;
#pragma unroll
    for (int i = 0; i < 8; ++i) { const int co = (i >> 1) * 512 + lane * 8 + (i & 1) * 4; v[i] = *(const f32x4*)(xr + co); w2[i] = *(const f32x4*)(xr + DM + co); }
#pragma unroll
    for (int i = 0; i < 8; ++i) { ss += v[i][0] * v[i][0] + v[i][1] * v[i][1] + v[i][2] * v[i][2] + v[i][3] * v[i][3]; s2 += w2[i][0] * w2[i][0] + w2[i][1] * w2[i][1] + w2[i][2] * w2[i][2] + w2[i][3] * w2[i][3]; }
    ss = wave_sum(ss); s2 = wave_sum(s2);
    const float rstd = rsqrtf(ss * (1.0f / 2048.0f) + 1e-6f), rstd2 = rsqrtf(s2 * (1.0f / 2048.0f) + 1e-6f);
#pragma unroll
    for (int i = 0; i < 4; ++i) { const f32x4 a0 = v[2 * i] * rstd * nw[2 * i], a1 = v[2 * i + 1] * rstd * nw[2 * i + 1], b0 = w2[2 * i] * rstd2 * nw[2 * i], b1 = w2[2 * i + 1] * rstd2 * nw[2 * i + 1];
      u32x4 o; o.x = cvt_pk_bf16(a0[0], a0[1]); o.y = cvt_pk_bf16(a0[2], a0[3]); o.z = cvt_pk_bf16(a1[0], a1[1]); o.w = cvt_pk_bf16(a1[2], a1[3]); *(u32x4*)(p.hn + (size_t)row * DM + i * 512 + lane * 8) = o;
      u32x4 o2; o2.x = cvt_pk_bf16(b0[0], b0[1]); o2.y = cvt_pk_bf16(b0[2], b0[3]); o2.z = cvt_pk_bf16(b1[0], b1[1]); o2.w = cvt_pk_bf16(b1[2], b1[3]); *(u32x4*)(p.hn + (size_t)(row + 1) * DM + i * 512 + lane * 8) = o2; }
  }
}
__device__ __forceinline__ void ph_gdown(const Params& p, LAS char* lds) {
  const int tid = otid(), wid = tid >> 6, lane = tid & 63, fr = lane & 15, fq = lane >> 4, rt = wid >> 2, kq = wid & 3;
  LAS float* part = (LAS float*)lds;
  for (int task = blockIdx.x; task < T_TOK / 32; task += gridDim.x) {
    const int row = task * 32 + rt * 16 + fr;
    const bf16_t* ar = p.hn + (size_t)row * DM + kq * 512 + fq * 8;
    const bf16_t* wh = p.wgd_hi + fr * 2048 + kq * 512 + fq * 8; const bf16_t* wl = p.wgd_lo + fr * 2048 + kq * 512 + fq * 8;
    f32x4 acc = {0.f, 0.f, 0.f, 0.f};
#pragma unroll 8
    for (int ks = 0; ks < 16; ++ks) { const bf16x8 a = *(const bf16x8*)(ar + ks * 32), bh = *(const bf16x8*)(wh + ks * 32), bl = *(const bf16x8*)(wl + ks * 32);
      acc = __builtin_amdgcn_mfma_f32_16x16x32_bf16(a, bh, acc, 0, 0, 0); acc = __builtin_amdgcn_mfma_f32_16x16x32_bf16(a, bl, acc, 0, 0, 0); }
    LAS float* pw_ = part + (rt * 4 + kq) * (16 * 17);
#pragma unroll
    for (int r = 0; r < 4; ++r) pw_[(fq * 4 + r) * 17 + fr] = acc[r];
    __syncthreads();
    if (tid < 512) { const int rr = tid >> 4, cc = tid & 15, rt2 = rr >> 4, r16 = rr & 15; const LAS float* q_ = part + (rt2 * 4) * (16 * 17) + r16 * 17 + cc;
      p.gd[(size_t)(task * 32 + rr) * 16 + cc] = q_[0] + q_[16 * 17] + q_[2 * 16 * 17] + q_[3 * 16 * 17]; }
    __syncthreads();
  }
}

__device__ __forceinline__ void ph_convert(const Params& p, LAS char* lds) {
  const int tid = otid();
  LAS float* tile = (LAS float*)lds;
  constexpr int NT_TOTAL = 1536 + 512;
  auto tile_src = [&](int tI, const float*& src, bf16_t*& dst, int& ld, int& k0, int& n0) { int ntn, local;
    if (tI < 1536) { src = p.w_in; dst = p.wt_in; ld = LDW; ntn = 48; local = tI; } else { src = p.w_out; dst = p.wt_out; ld = 2048; ntn = 16; local = tI - 1536; }
    const int tn = local % ntn, tk = local / ntn; k0 = tk * 64; n0 = tn * 128; };
  const int lr = tid >> 5, lc4 = (tid & 31) * 4;
  f32x4 pv[4];
  { const int tI = blockIdx.x; if (tI < NT_TOTAL) { const float* src; bf16_t* dst; int ld, k0, n0; tile_src(tI, src, dst, ld, k0, n0);
#pragma unroll
      for (int ps = 0; ps < 4; ++ps) pv[ps] = *(const f32x4*)(src + (size_t)(k0 + ps * 16 + lr) * ld + n0 + lc4); } }
  for (int tI = blockIdx.x; tI < NT_TOTAL; tI += gridDim.x) {
    const float* src; bf16_t* dst; int ld, k0, n0; tile_src(tI, src, dst, ld, k0, n0);
#pragma unroll
    for (int ps = 0; ps < 4; ++ps) *(LAS f32x4*)(tile + (ps * 16 + lr) * 132 + lc4) = pv[ps];
    __syncthreads();
    { const int tN = tI + gridDim.x; if (tN < NT_TOTAL) { const float* s2; bf16_t* d2; int ld2, k2, n2; tile_src(tN, s2, d2, ld2, k2, n2);
#pragma unroll
        for (int ps = 0; ps < 4; ++ps) pv[ps] = *(const f32x4*)(s2 + (size_t)(k2 + ps * 16 + lr) * ld2 + n2 + lc4); } }
    { const int n = tid >> 2, kq = (tid & 3) * 16; float f[16];
#pragma unroll
      for (int j = 0; j < 16; ++j) f[j] = tile[(kq + j) * 132 + n];
      u32x4 a, b; a.x = cvt_pk_bf16(f[0], f[1]); a.y = cvt_pk_bf16(f[2], f[3]); a.z = cvt_pk_bf16(f[4], f[5]); a.w = cvt_pk_bf16(f[6], f[7]);
      b.x = cvt_pk_bf16(f[8], f[9]); b.y = cvt_pk_bf16(f[10], f[11]); b.z = cvt_pk_bf16(f[12], f[13]); b.w = cvt_pk_bf16(f[14], f[15]);
      bf16_t* o = dst + (size_t)(n0 + n) * 2048 + k0 + kq; *(u32x4*)o = a; *(u32x4*)(o + 8) = b; }
    __syncthreads();
  }
  for (int i = blockIdx.x * 512 + tid; i < 2048 * 32; i += gridDim.x * 512) { const int d = i >> 5, e = i & 31; const float w = p.router_w[i];
    const bf16_t h = f2bf(w); const bf16_t l = f2bf(w - bf2f(h)); p.wr_hi[e * 2048 + d] = h; p.wr_lo[e * 2048 + d] = l; }
  for (int i = blockIdx.x * 512 + tid; i < 2048 * 16; i += gridDim.x * 512) { const int d = i >> 4, c = i & 15; const float w = p.w_in[(size_t)d * LDW + 6144 + c];
    const bf16_t h = f2bf(w); const bf16_t l = f2bf(w - bf2f(h)); p.wgd_hi[c * 2048 + d] = h; p.wgd_lo[c * 2048 + d] = l; }
}

struct EpiProj { bf16_t* O; int pm, pn, ld;
  __device__ __forceinline__ void operator()(const f32x4 (&acc)[2][2][4][2], int wr, int wc, int fr, int fq) const {
#pragma unroll
    for (int ai = 0; ai < 2; ++ai)
#pragma unroll
      for (int m = 0; m < 4; ++m) { bf16_t* rowp = O + (size_t)(pm * 256 + ai * 128 + wr * 64 + m * 16 + fr) * ld + pn * 256 + wc * 32 + 8 * fq;
#pragma unroll
        for (int bj = 0; bj < 2; ++bj) { const f32x4 v0 = acc[ai][bj][m][0], v1 = acc[ai][bj][m][1]; u32x4 w; w.x = cvt_pk_bf16(v0[0], v0[1]); w.y = cvt_pk_bf16(v0[2], v0[3]); w.z = cvt_pk_bf16(v1[0], v1[1]); w.w = cvt_pk_bf16(v1[2], v1[3]);
          *(u32x4*)(rowp + bj * 128) = w; } }
  } };
struct EpiProjK { bf16_t* O; const float* kw; int pm, pn;
  __device__ __forceinline__ void operator()(const f32x4 (&acc)[2][2][4][2], int wr, int wc, int fr, int fq) const {
    f32x4 w4[2][2];
#pragma unroll
    for (int bj = 0; bj < 2; ++bj) { w4[bj][0] = *(const f32x4*)(kw + bj * 32 + 8 * fq); w4[bj][1] = *(const f32x4*)(kw + bj * 32 + 8 * fq + 4); }
#pragma unroll
    for (int ai = 0; ai < 2; ++ai)
#pragma unroll
      for (int m = 0; m < 4; ++m) { bf16_t* rowp = O + (size_t)(pm * 256 + ai * 128 + wr * 64 + m * 16 + fr) * NP + pn * 256 + wc * 64 + 8 * fq;
        float ss = 0.f;
#pragma unroll
        for (int bj = 0; bj < 2; ++bj)
#pragma unroll
          for (int n = 0; n < 2; ++n) { const f32x4 v = acc[ai][bj][m][n]; ss += v[0] * v[0] + v[1] * v[1] + v[2] * v[2] + v[3] * v[3]; }
        ss += __shfl_xor(ss, 16); ss += __shfl_xor(ss, 32);
        const float rstd = rsqrtf(ss * (1.0f / 64.0f) + 1e-6f);
#pragma unroll
        for (int bj = 0; bj < 2; ++bj) { const f32x4 v0 = acc[ai][bj][m][0] * rstd * w4[bj][0], v1 = acc[ai][bj][m][1] * rstd * w4[bj][1];
          u32x4 w; w.x = cvt_pk_bf16(v0[0], v0[1]); w.y = cvt_pk_bf16(v0[2], v0[3]); w.z = cvt_pk_bf16(v1[0], v1[1]); w.w = cvt_pk_bf16(v1[2], v1[3]);
          *(u32x4*)(rowp + bj * 32) = w; } }
  } };
__device__ __forceinline__ void ph_inproj(const Params& p, LAS char* lds) {
  unsigned bo[2]; b_offsets<true>(bo);
  unsigned boK[2];
#pragma unroll
  for (int i = 0; i < 2; ++i) { int R, C; stage_rc(otid() * 16 + i * 8192, R, C); boK[i] = (unsigned)(((R >> 5) * 64 + perm32(R & 31)) * KDIM + C) * 2u; }
  int pre = 0;
  for (int u = blockIdx.x; u < 32 * 24; u += gridDim.x) {
    const int pm = u & 31, pn = u >> 5;
    unsigned ao[2][2];
#pragma unroll
    for (int h = 0; h < 2; ++h)
#pragma unroll
      for (int i = 0; i < 2; ++i) { int R, C; stage_rc(otid() * 16 + i * 8192, R, C); ao[h][i] = (unsigned)((pm * 256 + h * 128 + R) * KDIM + C) * 2u; }
    const int un = u + gridDim.x, pnn = un >> 5, nx = (un < 32 * 24 && (un & 31) == pm) ? 1 : 0, kn = (pnn >= 4 && pnn < 8) ? 1 : 0;
    const rsrc_t RB0n = mk_rsrc(p.wt_in + (size_t)(pnn * 256) * KDIM), RB1n = mk_rsrc(p.wt_in + (size_t)(pnn * 256 + (kn ? 32 : 128)) * KDIM);
    unsigned bon[2]; bon[0] = kn ? boK[0] : bo[0]; bon[1] = kn ? boK[1] : bo[1];
    if (pn >= 4 && pn < 8) { EpiProjK E{p.proj, p.k_norm_w, pm, pn};
      gemm_unit(lds, mk_rsrc(p.hn), ao, mk_rsrc(p.wt_in + (size_t)(pn * 256) * KDIM), mk_rsrc(p.wt_in + (size_t)(pn * 256 + 32) * KDIM), boK, E, pre, nx, RB0n, RB1n, bon); }
    else { EpiProj E{p.proj, pm, pn, NP};
      gemm_unit(lds, mk_rsrc(p.hn), ao, mk_rsrc(p.wt_in + (size_t)(pn * 256) * KDIM), mk_rsrc(p.wt_in + (size_t)(pn * 256 + 128) * KDIM), bo, E, pre, nx, RB0n, RB1n, bon); }
    pre = nx;
    __syncthreads();
  }
}

template <int KSTEPS> __device__ __forceinline__ f32x4 mma_tile(const LAS bf16_t* A, int lda, const LAS bf16_t* B, int ldb, int fr, int fq) {
  f32x4 c = {0.f, 0.f, 0.f, 0.f};
#pragma unroll
  for (int ks = 0; ks < KSTEPS; ++ks) { const bf16x8 a = *(const LAS bf16x8*)(A + fr * lda + ks * 32 + fq * 8); const bf16x8 b = *(const LAS bf16x8*)(B + fr * ldb + ks * 32 + fq * 8);
    c = __builtin_amdgcn_mfma_f32_16x16x32_bf16(a, b, c, 0, 0, 0); }
  return c;
}

constexpr int G_LQ = 136, G_LK = 72;
constexpr int G1_GD = 0, G1_PART = 4096, G1_QS = 6144, G1_KS = G1_QS + 64 * G_LQ * 2, G1_KHT = G1_KS + 64 * G_LQ * 2, G1_VI = G1_KHT + 128 * G_LK * 2, G1_AS = G1_VI + 64 * 512;
template <int OFF> __device__ __forceinline__ s16x4 trv(int vb) { s16x4 r; asm volatile("ds_read_b64_tr_b16 %0, %1 offset:%2" : "=v"(r) : "v"(vb), "i"(OFF) : "memory"); return r; }
__device__ __forceinline__ void ph_gla1(const Params& p, LAS char* lds) {
  const int tid = otid(), wid = tid >> 6, lane = tid & 63, fr = lane & 15, fq = lane >> 4;
  LAS float* gdS = (LAS float*)(lds + G1_GD); LAS float* partS = (LAS float*)(lds + G1_PART);
  LAS bf16_t* Qs = (LAS bf16_t*)(lds + G1_QS); LAS bf16_t* Ks = (LAS bf16_t*)(lds + G1_KS); LAS bf16_t* Kht = (LAS bf16_t*)(lds + G1_KHT);
  LAS char* VI = lds + G1_VI; LAS bf16_t* As = (LAS bf16_t*)(lds + G1_AS);
  const int q4 = fr >> 2, pp = lane & 3, fv = q4 | ((fq & 1) << 2);
  const int vlane = (int)(unsigned)(uintptr_t)VI + (8 * fq + q4) * 512 + pp * 8;
  int hprev = -1; float Wg[16] = {0.f, 0.f, 0.f, 0.f, 0.f, 0.f, 0.f, 0.f, 0.f, 0.f, 0.f, 0.f, 0.f, 0.f, 0.f, 0.f}; float bias = 0.f;
  u32x4 vv[4], qq[2], kk[2]; f32x4 gg = {0.f, 0.f, 0.f, 0.f};
  auto stage_load = [&](int uu) { const int b2 = uu >> 7, h2 = (uu >> 5) & 3, c2 = uu & 31; const size_t tt = (size_t)b2 * SEQ + c2 * 64;
    if (tid < 256) gg = *(const f32x4*)(p.gd + tt * 16 + tid * 4);
#pragma unroll
    for (int i = 0; i < 4; ++i) { const int pc = tid + i * 512, j = pc >> 5, e8 = (pc & 31) * 8; vv[i] = *(const u32x4*)(p.proj + (tt + j) * NP + 4096 + h2 * 256 + e8); }
#pragma unroll
    for (int i = 0; i < 2; ++i) { const int pc = tid + i * 512, row = pc >> 4, c8 = (pc & 15) * 8; const bf16_t* src = p.proj + (tt + row) * NP + 3072 + h2 * 128 + c8;
      qq[i] = *(const u32x4*)src; kk[i] = *(const u32x4*)(src + 512); } };
  if ((int)blockIdx.x < 512) stage_load(blockIdx.x);
  for (int u = blockIdx.x; u < 512; u += gridDim.x) {
    const int b = u >> 7, h = (u >> 5) & 3, c = u & 31; const size_t t0 = (size_t)b * SEQ + c * 64;
    const int d = tid & 127, qt = tid >> 7;
    if (h != hprev) { hprev = h;
#pragma unroll
      for (int r = 0; r < 16; ++r) Wg[r] = p.gate_up_w[r * 512 + h * 128 + d];
      bias = p.gate_up_b[h * 128 + d]; }
    { if (tid < 256) *(LAS f32x4*)(gdS + tid * 4) = gg;
#pragma unroll
      for (int i = 0; i < 4; ++i) { const int pc = tid + i * 512, j = pc >> 5, e8 = (pc & 31) * 8, fj = (j & 3) | (((j >> 3) & 1) << 2);
        *(LAS u32x4*)(VI + j * 512 + (((e8 >> 4) ^ fj) << 5) + (e8 & 15) * 2) = vv[i]; }
#pragma unroll
      for (int i = 0; i < 2; ++i) { const int pc = tid + i * 512, row = pc >> 4, c8 = (pc & 15) * 8; *(LAS u32x4*)(Qs + row * G_LQ + c8) = qq[i]; *(LAS u32x4*)(Ks + row * G_LQ + c8) = kk[i]; } }
    __syncthreads();
    if (u + (int)gridDim.x < 512) stage_load(u + gridDim.x);
    float bc[16]; float run = 0.f;
#pragma unroll
    for (int ii = 0; ii < 16; ++ii) { const int i = qt * 16 + ii; float xg = bias;
#pragma unroll
      for (int r4 = 0; r4 < 4; ++r4) { const f32x4 g4 = *(const LAS f32x4*)(gdS + i * 16 + r4 * 4); xg += g4[0] * Wg[r4 * 4] + g4[1] * Wg[r4 * 4 + 1] + g4[2] * Wg[r4 * 4 + 2] + g4[3] * Wg[r4 * 4 + 3]; }
      const float ls = fminf(xg, 0.f) - __logf(1.0f + __expf(-fabsf(xg)));
      run += ls * (1.0f / 16.0f); bc[ii] = run; }
    partS[qt * 128 + d] = run;
    __syncthreads();
    float pre = 0.f, tot = 0.f;
#pragma unroll
    for (int q = 0; q < 4; ++q) { const float v = partS[q * 128 + d]; tot += v; pre += (q < qt) ? v : 0.f; }
    const float etot = __expf(tot);
    if (qt == 0) p.decay[u * 128 + d] = etot;
    { unsigned kh[8];
#pragma unroll
      for (int ii = 0; ii < 16; ++ii) { const int i = qt * 16 + ii; const float bb = bc[ii] + pre; const float qv = bf2f(Qs[i * G_LQ + d]), kv = bf2f(Ks[i * G_LQ + d]);
        const float eb = __expf(bb), ib = __builtin_amdgcn_rcpf(eb);
        Qs[i * G_LQ + d] = f2bf(qv * 0.08838834764831845f * eb);
        Ks[i * G_LQ + d] = f2bf(kv * ib);
        const unsigned khv = f2bf(kv * (etot * ib)); if (ii & 1) kh[ii >> 1] |= khv << 16; else kh[ii >> 1] = khv; }
      *(LAS u32x4*)(Kht + d * G_LK + qt * 16) = (u32x4){kh[0], kh[1], kh[2], kh[3]}; *(LAS u32x4*)(Kht + d * G_LK + qt * 16 + 8) = (u32x4){kh[4], kh[5], kh[6], kh[7]}; }
    __syncthreads();
#pragma unroll
    for (int i = 0; i < 2; ++i) { const int pc = tid + i * 512, row = pc >> 4, c8 = (pc & 15) * 8; *(u32x4*)(p.qtil + ((size_t)u * 64 + row) * 128 + c8) = *(const LAS u32x4*)(Qs + row * G_LQ + c8); }
    { const int mt = wid >> 1;
#pragma unroll
      for (int q = 0; q < 2; ++q) { const int nt = (wid & 1) * 2 + q; const f32x4 cc = mma_tile<4>(Qs + mt * 16 * G_LQ, G_LQ, Ks + nt * 16 * G_LQ, G_LQ, fr, fq);
#pragma unroll
        for (int r = 0; r < 4; ++r) { const int i = mt * 16 + fq * 4 + r, j = nt * 16 + fr; As[i * G_LK + j] = f2bf(j <= i ? cc[r] : 0.f); } } }
    __syncthreads();
    { bf16_t* oi = p.oib + (size_t)u * 64 * 256; bf16_t* Uo = p.Ub + (size_t)u * 256 * 128; const int odd = fq & 1, c16 = (odd ? 16 : 0) + 8 * (fq >> 1);
      f32x4 oc[2][4];
#pragma unroll
      for (int q = 0; q < 2; ++q) { const int tq = wid * 2 + q;
        const int va = vlane + ((tq ^ fv) << 5);
        const s16x4 l0 = trv<0>(va), h0 = trv<2048>(va), l1 = trv<16384>(va), h1 = trv<16384 + 2048>(va);
        asm volatile("s_waitcnt lgkmcnt(0)" ::: "memory"); __builtin_amdgcn_sched_barrier(0);
        const bf16x8 vf0 = (bf16x8){l0[0], l0[1], l0[2], l0[3], h0[0], h0[1], h0[2], h0[3]}, vf1 = (bf16x8){l1[0], l1[1], l1[2], l1[3], h1[0], h1[1], h1[2], h1[3]};
#pragma unroll
        for (int mt = 0; mt < 4; ++mt) {
          const bf16x8 a0 = *(const LAS bf16x8*)(As + (mt * 16 + fr) * G_LK + fq * 8), a1 = *(const LAS bf16x8*)(As + (mt * 16 + fr) * G_LK + 32 + fq * 8);
          f32x4 cc = {0.f, 0.f, 0.f, 0.f}; cc = __builtin_amdgcn_mfma_f32_16x16x32_bf16(vf0, a0, cc, 0, 0, 0); cc = __builtin_amdgcn_mfma_f32_16x16x32_bf16(vf1, a1, cc, 0, 0, 0);
          oc[q][mt] = cc; }
#pragma unroll
        for (int np = 0; np < 4; ++np) {
          u32x2 wq[2];
#pragma unroll
          for (int z = 0; z < 2; ++z) { const int nt = np * 2 + z;
            const bf16x8 a0 = *(const LAS bf16x8*)(Kht + (nt * 16 + fr) * G_LK + fq * 8), a1 = *(const LAS bf16x8*)(Kht + (nt * 16 + fr) * G_LK + 32 + fq * 8);
            f32x4 cc = {0.f, 0.f, 0.f, 0.f}; cc = __builtin_amdgcn_mfma_f32_16x16x32_bf16(a0, vf0, cc, 0, 0, 0); cc = __builtin_amdgcn_mfma_f32_16x16x32_bf16(a1, vf1, cc, 0, 0, 0);
            wq[z].x = pkc(cc[0], cc[1]); wq[z].y = pkc(cc[2], cc[3]); }
          u32x4 w; quad_pair16(wq[0], wq[1], odd, w);
          *(u32x4*)(Uo + (tq * 16 + fr) * 128 + np * 32 + c16) = w; } }
#pragma unroll
      for (int mt = 0; mt < 4; ++mt) { u32x2 w0, w1; w0.x = pkc(oc[0][mt][0], oc[0][mt][1]); w0.y = pkc(oc[0][mt][2], oc[0][mt][3]); w1.x = pkc(oc[1][mt][0], oc[1][mt][1]); w1.y = pkc(oc[1][mt][2], oc[1][mt][3]);
        u32x4 w; quad_pair16(w0, w1, odd, w);
        *(u32x4*)(oi + (mt * 16 + fr) * 256 + wid * 32 + c16) = w; } }
    __syncthreads();
  }
}

__device__ __forceinline__ void ph_gla_scan(const Params& p, LAS char* lds) {
  const int tid = otid(); LAS float* decS = (LAS float*)lds;
  for (int w = blockIdx.x; w < 256; w += gridDim.x) {
    const int bh = w >> 4, e = (w & 15) * 16 + ((tid & 255) >> 4), d8 = (tid & 15) * 8;
#pragma unroll
    for (int i = 0; i < 2; ++i) *(LAS f32x4*)(decS + (tid + i * 512) * 4) = *(const f32x4*)(p.decay + (size_t)bh * 4096 + (tid + i * 512) * 4);
    __syncthreads();
    if (tid < 256) {
      f32x4 S0 = {0.f, 0.f, 0.f, 0.f}, S1 = {0.f, 0.f, 0.f, 0.f};
      u32x4 uv[2][8];
#pragma unroll
      for (int c = 0; c < 8; ++c) uv[0][c] = *(const u32x4*)(p.Ub + ((size_t)(bh * 32 + c) * 256 + e) * 128 + d8);
#pragma unroll
      for (int hb = 0; hb < 4; ++hb) {
        if (hb < 3) {
#pragma unroll
          for (int c = 0; c < 8; ++c) uv[(hb + 1) & 1][c] = *(const u32x4*)(p.Ub + ((size_t)(bh * 32 + (hb + 1) * 8 + c) * 256 + e) * 128 + d8); }
#pragma unroll
        for (int c = 0; c < 8; ++c) { const int cc = hb * 8 + c; const size_t off = ((size_t)(bh * 32 + cc) * 256 + e) * 128 + d8;
          u32x4 o; o.x = cvt_pk_bf16(S0[0], S0[1]); o.y = cvt_pk_bf16(S0[2], S0[3]); o.z = cvt_pk_bf16(S1[0], S1[1]); o.w = cvt_pk_bf16(S1[2], S1[3]); *(u32x4*)(p.st + off) = o;
          const u32x4 uu = uv[hb & 1][c]; const f32x4 dc0 = *(const LAS f32x4*)(decS + cc * 128 + d8), dc1 = *(const LAS f32x4*)(decS + cc * 128 + d8 + 4);
          const f32x4 u0 = {bflo(uu.x), bfhi(uu.x), bflo(uu.y), bfhi(uu.y)}, u1 = {bflo(uu.z), bfhi(uu.z), bflo(uu.w), bfhi(uu.w)};
          S0 = dc0 * S0 + u0; S1 = dc1 * S1 + u1; } }
    }
    __syncthreads();
  }
}

constexpr int G3_QS = 0, G3_SS = 64 * G_LQ * 2, G3_OS = 0, G3_LO = 260;
__device__ __forceinline__ void ph_gla3(const Params& p, LAS char* lds) {
  const int tid = otid(), wid = tid >> 6, lane = tid & 63, fr = lane & 15, fq = lane >> 4;
  LAS bf16_t* Qs = (LAS bf16_t*)(lds + G3_QS); LAS bf16_t* Ss = (LAS bf16_t*)(lds + G3_SS); LAS float* Os = (LAS float*)(lds + G3_OS);
  u32x4 qv[2], sv[8];
  auto stage_load = [&](int uu) {
#pragma unroll
    for (int i = 0; i < 2; ++i) { const int pc = tid + i * 512, row = pc >> 4, cc = (pc & 15) * 8; qv[i] = *(const u32x4*)(p.qtil + ((size_t)uu * 64 + row) * 128 + cc); }
#pragma unroll
    for (int i = 0; i < 8; ++i) { const int pc = tid + i * 512, row = pc >> 4, cc = (pc & 15) * 8; sv[i] = *(const u32x4*)(p.st + ((size_t)uu * 256 + row) * 128 + cc); } };
  if ((int)blockIdx.x < 512) stage_load(blockIdx.x);
  for (int u = blockIdx.x; u < 512; u += gridDim.x) {
    const int b = u >> 7, h = (u >> 5) & 3, c = u & 31; const size_t t0 = (size_t)b * SEQ + c * 64;
#pragma unroll
    for (int i = 0; i < 2; ++i) { const int pc = tid + i * 512, row = pc >> 4, cc = (pc & 15) * 8; *(LAS u32x4*)(Qs + row * G_LQ + cc) = qv[i]; }
#pragma unroll
    for (int i = 0; i < 8; ++i) { const int pc = tid + i * 512, row = pc >> 4, cc = (pc & 15) * 8; *(LAS u32x4*)(Ss + row * G_LQ + cc) = sv[i]; }
    u32x2 obv[2][4]; u32x4 rrv[4];
    { const bf16_t* oi = p.oib + (size_t)u * 64 * 256;
#pragma unroll
      for (int q = 0; q < 2; ++q)
#pragma unroll
        for (int mt = 0; mt < 4; ++mt) obv[q][mt] = *(const u32x2*)(oi + (mt * 16 + fr) * 256 + (wid * 2 + q) * 16 + fq * 4);
      const bf16_t* rp0 = p.proj + (t0 + (tid >> 3)) * NP + 5120 + h * 256 + (tid & 7) * 32;
#pragma unroll
      for (int q = 0; q < 4; ++q) rrv[q] = *(const u32x4*)(rp0 + q * 8); }
    __syncthreads();
    if (u + (int)gridDim.x < 512) stage_load(u + gridDim.x);
    f32x4 res[2][4];
#pragma unroll
    for (int q = 0; q < 2; ++q) { const int nt = wid * 2 + q;
#pragma unroll
      for (int mt = 0; mt < 4; ++mt) { const f32x4 cc = mma_tile<4>(Ss + nt * 16 * G_LQ, G_LQ, Qs + mt * 16 * G_LQ, G_LQ, fr, fq);
        const u32x2 ob = obv[q][mt]; res[q][mt] = cc + (f32x4){bflo(ob.x), bfhi(ob.x), bflo(ob.y), bfhi(ob.y)}; } }
    __syncthreads();
#pragma unroll
    for (int q = 0; q < 2; ++q) { const int nt = wid * 2 + q;
#pragma unroll
      for (int mt = 0; mt < 4; ++mt) *(LAS f32x4*)(Os + (mt * 16 + fr) * G3_LO + nt * 16 + fq * 4) = res[q][mt]; }
    __syncthreads();
    { const int i = tid >> 3, seg = tid & 7; float v[32]; float ss = 0.f;
#pragma unroll
      for (int q = 0; q < 8; ++q) { const f32x4 x = *(const LAS f32x4*)(Os + i * G3_LO + seg * 32 + q * 4); v[q * 4] = x[0]; v[q * 4 + 1] = x[1]; v[q * 4 + 2] = x[2]; v[q * 4 + 3] = x[3]; ss += x[0] * x[0] + x[1] * x[1] + x[2] * x[2] + x[3] * x[3]; }
      ss += __shfl_xor(ss, 1); ss += __shfl_xor(ss, 2); ss += __shfl_xor(ss, 4);
      const float rstd = rsqrtf(ss * (1.0f / 256.0f) + 1e-6f);
      bf16_t* op = p.mix + (t0 + i) * DM + 1024 + h * 256 + seg * 32; const float* nw = p.gla_norm_w + seg * 32;
#pragma unroll
      for (int q = 0; q < 4; ++q) { const u32x4 rr = rrv[q]; const float rf[8] = {bflo(rr.x), bfhi(rr.x), bflo(rr.y), bfhi(rr.y), bflo(rr.z), bfhi(rr.z), bflo(rr.w), bfhi(rr.w)}; float o8[8];
#pragma unroll
        for (int j = 0; j < 8; ++j) { const float r = rf[j]; const float sl = r * __builtin_amdgcn_rcpf(1.0f + __expf(-r)); o8[j] = v[q * 8 + j] * rstd * nw[q * 8 + j] * sl; }
        u32x4 w; w.x = cvt_pk_bf16(o8[0], o8[1]); w.y = cvt_pk_bf16(o8[2], o8[3]); w.z = cvt_pk_bf16(o8[4], o8[5]); w.w = cvt_pk_bf16(o8[6], o8[7]); *(u32x4*)(op + q * 8) = w; } }
    __syncthreads();
  }
}

constexpr int SHM_KV = 64 * 128 * 2;
#define KSWZ(row, colB) ((row) * 256 + ((colB) ^ (((row) & 7) << 4)))
#define SBAR() __builtin_amdgcn_sched_barrier(0)
__device__ __forceinline__ int crow(int r, int hi) { return (r & 3) + 8 * (r >> 2) + 4 * hi; }
constexpr float ATT_THR = 14.0f;
template <bool FAST> __device__ __forceinline__ void partialSM(f32x16& p0, f32x16& p1, float& m_reg, float& mn, float& alpha) {
  if constexpr (FAST) {
#pragma unroll
    for (int r = 0; r < 16; ++r) p0[r] = __builtin_amdgcn_exp2f(p0[r]);
    return; }
  float pmax = p0[0];
#pragma unroll
  for (int r = 1; r < 16; ++r) pmax = fmaxf(pmax, p0[r]);
#pragma unroll
  for (int r = 0; r < 16; ++r) pmax = fmaxf(pmax, p1[r]);
  { auto rr = __builtin_amdgcn_permlane32_swap(__float_as_uint(pmax), __float_as_uint(pmax), false, false); pmax = fmaxf(__uint_as_float(rr[0]), __uint_as_float(rr[1])); }
  if (__builtin_expect(__all(pmax - m_reg <= ATT_THR), 1)) { mn = m_reg; alpha = 1.f; }
  else { mn = fmaxf(m_reg, pmax); alpha = __builtin_amdgcn_exp2f(m_reg - mn); m_reg = mn; }
#pragma unroll
  for (int r = 0; r < 16; ++r) p0[r] = p0[r] - mn;
#pragma unroll
  for (int r = 0; r < 16; ++r) p1[r] = p1[r] - mn;
#pragma unroll
  for (int r = 0; r < 16; ++r) p0[r] = __builtin_amdgcn_exp2f(p0[r]);
}
template <bool FAST> __device__ __forceinline__ void finishSM(f32x16& p0, f32x16& p1, float alpha, float& l_reg, bf16x8& pa0, bf16x8& pa1, bf16x8& pa2, bf16x8& pa3) {
#pragma unroll
  for (int r = 0; r < 16; ++r) p1[r] = __builtin_amdgcn_exp2f(p1[r]);
  float ps = 0;
#pragma unroll
  for (int r = 0; r < 16; ++r) ps += p0[r];
#pragma unroll
  for (int r = 0; r < 16; ++r) ps += p1[r];
  { auto rr = __builtin_amdgcn_permlane32_swap(__float_as_uint(ps), __float_as_uint(ps), false, false); ps = __uint_as_float(rr[0]) + __uint_as_float(rr[1]); }
  if constexpr (FAST) l_reg += ps; else l_reg = l_reg * alpha + ps;
#define PK4(P, BASE, OUT) do { unsigned a0 = cvt_pk_bf16(P[BASE + 0], P[BASE + 1]), a1 = cvt_pk_bf16(P[BASE + 2], P[BASE + 3]);   \
    unsigned b0 = cvt_pk_bf16(P[BASE + 4], P[BASE + 5]), b1 = cvt_pk_bf16(P[BASE + 6], P[BASE + 7]);                              \
    auto r0 = __builtin_amdgcn_permlane32_swap(a0, b0, false, false); auto r1 = __builtin_amdgcn_permlane32_swap(a1, b1, false, false); \
    u32x4 w = {r0[0], r1[0], r0[1], r1[1]}; OUT = *reinterpret_cast<bf16x8*>(&w); } while (0)
  PK4(p0, 0, pa0); PK4(p0, 8, pa1); PK4(p1, 0, pa2); PK4(p1, 8, pa3);
#undef PK4
}
__device__ __forceinline__ void qkt(f32x16& p0, f32x16& p1, const LAS char* Ks, const bf16x8* qr, int r32, int hi, int mapc) {
  p0 = f32x16{}; p1 = f32x16{};
#pragma unroll
  for (int d0 = 0; d0 < 4; ++d0) { const int cb = (mapc + d0 * 16 + hi * 8) * 2;
    const bf16x8 b0 = *(const LAS bf16x8*)(Ks + KSWZ(r32, cb));
    const bf16x8 b1 = *(const LAS bf16x8*)(Ks + KSWZ(32 + r32, cb));
    p0 = __builtin_amdgcn_mfma_f32_32x32x16_bf16(b0, qr[d0], p0, 0, 0, 0);
    p1 = __builtin_amdgcn_mfma_f32_32x32x16_bf16(b1, qr[d0], p1, 0, 0, 0); }
}
__device__ __forceinline__ int v_st(int k, int c) { const int kk = (k & ~0xC) | ((k & 4) << 1) | ((k & 8) >> 1); return ((kk >> 3) * 4 + (c >> 5)) * 512 + ((kk & 7) * 32 + (c & 31)) * 2; }
__device__ __forceinline__ int v_rd_base(int lane) { return ((lane & 3) << 3) | (((lane >> 2) & 3) << 6) | (((lane >> 4) & 1) << 5) | (((lane >> 5) & 1) << 8); }
constexpr int v_rd_off(int d0, int ks, int half) { return d0 * 512 + ks * 4096 + half * 2048; }
template <int OFF> __device__ __forceinline__ s16x4 tr_read(int vb) { s16x4 r; asm volatile("ds_read_b64_tr_b16 %0, %1 offset:%2" : "=&v"(r) : "v"(vb), "i"(OFF) : "memory"); return r; }
template <int D0> __device__ __forceinline__ void pv_one(f32x16& od, int vb, bf16x8 pa0, bf16x8 pa1, bf16x8 pa2, bf16x8 pa3) {
  const s16x4 l0 = tr_read<v_rd_off(D0, 0, 0)>(vb), h0 = tr_read<v_rd_off(D0, 0, 1)>(vb), l1 = tr_read<v_rd_off(D0, 1, 0)>(vb), h1 = tr_read<v_rd_off(D0, 1, 1)>(vb);
  const s16x4 l2 = tr_read<v_rd_off(D0, 2, 0)>(vb), h2 = tr_read<v_rd_off(D0, 2, 1)>(vb), l3 = tr_read<v_rd_off(D0, 3, 0)>(vb), h3 = tr_read<v_rd_off(D0, 3, 1)>(vb);
  asm volatile("s_waitcnt lgkmcnt(0)" ::: "memory"); SBAR();
#define PK(L, H) (bf16x8){L[0], L[1], L[2], L[3], H[0], H[1], H[2], H[3]}
  od = __builtin_amdgcn_mfma_f32_32x32x16_bf16(pa0, PK(l0, h0), od, 0, 0, 0);
  od = __builtin_amdgcn_mfma_f32_32x32x16_bf16(pa1, PK(l1, h1), od, 0, 0, 0);
  od = __builtin_amdgcn_mfma_f32_32x32x16_bf16(pa2, PK(l2, h2), od, 0, 0, 0);
  od = __builtin_amdgcn_mfma_f32_32x32x16_bf16(pa3, PK(l3, h3), od, 0, 0, 0);
#undef PK
}
__device__ __forceinline__ void pv_d0(f32x16* o, int vb, bf16x8 pa0, bf16x8 pa1, bf16x8 pa2, bf16x8 pa3) {
  pv_one<0>(o[0], vb, pa0, pa1, pa2, pa3); pv_one<1>(o[1], vb, pa0, pa1, pa2, pa3); pv_one<2>(o[2], vb, pa0, pa1, pa2, pa3); pv_one<3>(o[3], vb, pa0, pa1, pa2, pa3);
}

template <bool FAST> __device__ __forceinline__ void attn_unit(const Params& p, LAS char* lds, int b, int h, int qb, float lam) {
  const int tid = otid(), wid = __builtin_amdgcn_readfirstlane(tid >> 6), lane = tid & 63, r32 = lane & 31, hi = lane >> 5;
  const int map = wid >> 2, wq = wid & 3, mapc = map * 64;
  LAS char* V_lds = lds; LAS char* K_lds = lds + 3 * SHM_KV;
  LAS float* wsf = (LAS float*)(lds + 6 * SHM_KV) + wid * 64; LAS float* li_l = wsf; LAS float* al_l = wsf + 32;
  const int i0 = qb * 128, NT = 2 * qb + 2; const bool masked = (wq < 2);
  float m_reg = -1e30f, l_reg = 0; f32x16 o[4] = {}; bf16x8 qr[4];
  const bf16_t* Qw = p.proj + ((size_t)b * SEQ + i0 + wq * 32 + r32) * NP + h * 128 + mapc + hi * 8;
  {
    u32x4 qraw[4]; float qf[4][8]; float ss = 0.f;
#pragma unroll
    for (int d0 = 0; d0 < 4; ++d0) qraw[d0] = *(const u32x4*)(Qw + d0 * 16);
#pragma unroll
    for (int d0 = 0; d0 < 4; ++d0) { const u32x4 r = qraw[d0]; qf[d0][0] = bflo(r.x); qf[d0][1] = bfhi(r.x); qf[d0][2] = bflo(r.y); qf[d0][3] = bfhi(r.y); qf[d0][4] = bflo(r.z); qf[d0][5] = bfhi(r.z); qf[d0][6] = bflo(r.w); qf[d0][7] = bfhi(r.w);
#pragma unroll
      for (int j = 0; j < 8; ++j) ss += qf[d0][j] * qf[d0][j]; }
    ss += __shfl_xor(ss, 32);
    const float rs = rsqrtf(ss * (1.0f / 64.0f) + 1e-6f) * (0.125f * 1.4426950408889634f);
#pragma unroll
    for (int d0 = 0; d0 < 4; ++d0) { const f32x4 w0 = *(const f32x4*)(p.q_norm_w + d0 * 16 + hi * 8), w1 = *(const f32x4*)(p.q_norm_w + d0 * 16 + hi * 8 + 4);
      u32x4 o; o.x = cvt_pk_bf16(qf[d0][0] * rs * w0[0], qf[d0][1] * rs * w0[1]); o.y = cvt_pk_bf16(qf[d0][2] * rs * w0[2], qf[d0][3] * rs * w0[3]);
      o.z = cvt_pk_bf16(qf[d0][4] * rs * w1[0], qf[d0][5] * rs * w1[1]); o.w = cvt_pk_bf16(qf[d0][6] * rs * w1[2], qf[d0][7] * rs * w1[3]);
      qr[d0] = *reinterpret_cast<bf16x8*>(&o); } }
  const rsrc_t RK = mk_rsrc(p.proj + (size_t)b * SEQ * NP + 1024 + h * 128);
  const int sr = tid >> 4, sc = (tid & 15) * 8, vst0 = v_st(sr, sc), vst1 = v_st(32 + sr, sc); const unsigned soff = (unsigned)(sr * NP + sc) * 2u;
  const int vb0 = (int)(unsigned)(uintptr_t)V_lds + v_rd_base(lane);
  struct { bf16x8 vs0, vs1, ks0, ks1; } sr_[2];
#define BL128(so) ({ u32x4 _t = __builtin_amdgcn_raw_buffer_load_b128(RK, (int)soff, (int)(so), 0); *reinterpret_cast<bf16x8*>(&_t); })
#define SLOAD(i, k0) do { const unsigned _s0 = (unsigned)(k0) * (NP * 2), _s1 = _s0 + 32 * NP * 2; \
    sr_[i].vs0 = BL128(_s0 + 2048); sr_[i].vs1 = BL128(_s1 + 2048); sr_[i].ks0 = BL128(_s0); sr_[i].ks1 = BL128(_s1); } while (0)
#define SWRITE(off, i) do { *(LAS bf16x8*)(V_lds + (off) + vst0) = sr_[i].vs0; *(LAS bf16x8*)(V_lds + (off) + vst1) = sr_[i].vs1; const int kc = sc * 2; \
    *(LAS bf16x8*)(K_lds + (off) + KSWZ(sr, kc)) = sr_[i].ks0; *(LAS bf16x8*)(K_lds + (off) + KSWZ(32 + sr, kc)) = sr_[i].ks1; } while (0)
#define SWAIT() asm volatile("s_waitcnt vmcnt(4)" ::: "memory")
#define RESC(a) do { if constexpr (!FAST) if (__any((a) < 1.f)) { if (hi == 0) al_l[r32] = (a); asm volatile("s_waitcnt lgkmcnt(0)" ::: "memory"); \
    _Pragma("unroll") for (int d = 0; d < 4; ++d) _Pragma("unroll") for (int r = 0; r < 16; ++r) o[d][r] *= al_l[crow(r, hi)]; } } while (0)
  f32x16 pA0, pA1, pB0, pB1; float mnA = 0.f, mnB = 0.f, alA = 1.f, alB = 1.f; bf16x8 pa0, pa1, pa2, pa3;
  int offV = 0, offK = SHM_KV, offW = 2 * SHM_KV;
#define ROT3() do { const int _t = offV; offV = offK; offK = offW; offW = _t; } while (0)
  SLOAD(0, 0); asm volatile("s_waitcnt vmcnt(0)" ::: "memory"); SWRITE(0, 0); __syncthreads();
  qkt(pA0, pA1, K_lds, qr, r32, hi, mapc); partialSM<FAST>(pA0, pA1, m_reg, mnA, alA);
  SLOAD(1, 64); if (2 < NT) SLOAD(0, 128);
  SWAIT(); SWRITE(SHM_KV, 1); __syncthreads();
  for (int j = 1; j + 1 < NT; j += 2) {
    SBAR(); qkt(pB0, pB1, K_lds + offK, qr, r32, hi, mapc);
    finishSM<FAST>(pA0, pA1, alA, l_reg, pa0, pa1, pa2, pa3); SBAR();
    SLOAD(1, (j + 2) * 64); SBAR();
    pv_d0(o, vb0 + offV, pa0, pa1, pa2, pa3); partialSM<FAST>(pB0, pB1, m_reg, mnB, alB);
    SWAIT(); SWRITE(offW, 0);
    RESC(alB); __syncthreads(); ROT3();
    SBAR(); qkt(pA0, pA1, K_lds + offK, qr, r32, hi, mapc);
    finishSM<FAST>(pB0, pB1, alB, l_reg, pa0, pa1, pa2, pa3); SBAR();
    if (j + 3 < NT) SLOAD(0, (j + 3) * 64); SBAR();
    pv_d0(o, vb0 + offV, pa0, pa1, pa2, pa3); partialSM<FAST>(pA0, pA1, m_reg, mnA, alA);
    SWAIT(); SWRITE(offW, 1);
    RESC(alA); __syncthreads(); ROT3();
  }
  SBAR(); qkt(pB0, pB1, K_lds + offK, qr, r32, hi, mapc);
  if (masked) {
#pragma unroll
    for (int r = 0; r < 16; ++r) { pB0[r] = -1e30f; pB1[r] = -1e30f; } }
  finishSM<FAST>(pA0, pA1, alA, l_reg, pa0, pa1, pa2, pa3); SBAR();
  pv_d0(o, vb0 + offV, pa0, pa1, pa2, pa3); partialSM<FAST>(pB0, pB1, m_reg, mnB, alB);
  RESC(alB);
  finishSM<FAST>(pB0, pB1, alB, l_reg, pa0, pa1, pa2, pa3); SBAR();
  pv_d0(o, vb0 + offK, pa0, pa1, pa2, pa3);
#undef ROT3
  if (hi == 0) li_l[r32] = l_reg; asm volatile("s_waitcnt lgkmcnt(0)" ::: "memory");
  const float sgn = map ? -lam : 1.0f;
#pragma unroll
  for (int r = 0; r < 16; ++r) { const float rl = __builtin_amdgcn_rcpf(li_l[crow(r, hi)]) * sgn;
#pragma unroll
    for (int d = 0; d < 4; ++d) o[d][r] *= rl; }
  __syncthreads();
  LAS float* xch = (LAS float*)lds;
  if (map == 1) {
#pragma unroll
    for (int d = 0; d < 4; ++d)
#pragma unroll
      for (int r = 0; r < 16; ++r) xch[(wq * 64 + d * 16 + r) * 64 + lane] = o[d][r]; }
  __syncthreads();
  if (map == 0) {
    float subw[4];
#pragma unroll
    for (int d = 0; d < 4; ++d) subw[d] = p.subln_w[d * 32 + r32] * 0.8f;
#pragma unroll
    for (int r = 0; r < 16; ++r) { float ss = 0.f;
#pragma unroll
      for (int d = 0; d < 4; ++d) { o[d][r] += xch[(wq * 64 + d * 16 + r) * 64 + lane]; ss += o[d][r] * o[d][r]; }
      ss += __shfl_xor(ss, 1); ss += __shfl_xor(ss, 2); ss += __shfl_xor(ss, 4); ss += __shfl_xor(ss, 8); ss += __shfl_xor(ss, 16);
      const float rs = rsqrtf(ss * (1.0f / 128.0f) + 1e-6f);
#pragma unroll
      for (int d = 0; d < 4; ++d) xch[(wq * 64 + d * 16 + r) * 64 + lane] = o[d][r] * rs * subw[d]; }
  }
  __syncthreads();
#pragma unroll
  for (int it = 0; it < 4; ++it) { const int idx = it * 512 + tid, c8 = idx & 15, row = idx >> 4, wq2 = row >> 5, rho = row & 31;
    const int r = (rho & 3) + 4 * (rho >> 3), hi2 = (rho >> 2) & 1, d = c8 >> 2;
    const LAS float* src = xch + (wq2 * 64 + d * 16 + r) * 64 + hi2 * 32 + (c8 & 3) * 8;
    const f32x4 v0 = *(const LAS f32x4*)src, v1 = *(const LAS f32x4*)(src + 4);
    u32x4 w; w.x = cvt_pk_bf16(v0[0], v0[1]); w.y = cvt_pk_bf16(v0[2], v0[3]); w.z = cvt_pk_bf16(v1[0], v1[1]); w.w = cvt_pk_bf16(v1[2], v1[3]);
    *(u32x4*)(p.mix + ((size_t)b * SEQ + i0 + row) * DM + h * 128 + c8 * 8) = w; }
  __syncthreads();
#undef SLOAD
#undef BL128
#undef SWRITE
#undef SWAIT
#undef RESC
}
__device__ __forceinline__ void ph_attn(const Params& p, LAS char* lds) {
  const int lane = otid() & 63;
  const float s1 = wave_sum(p.lq1[lane] * p.lk1[lane]), s2 = wave_sum(p.lq2[lane] * p.lk2[lane]);
  const float lam = expf(s1) - expf(s2) + 0.2f;
  float mq = fabsf(p.q_norm_w[lane]), mk = fabsf(p.k_norm_w[lane]);
#pragma unroll
  for (int o = 1; o < 64; o <<= 1) { mq = fmaxf(mq, __shfl_xor(mq, o)); mk = fmaxf(mk, __shfl_xor(mk, o)); }
  const float bound = 64.0f * 0.125f * 1.4426950408889634f * 1.01f * mq * mk;
  const bool fast = __builtin_amdgcn_readfirstlane(bound <= 24.0f ? 1 : 0) != 0;
  for (int u = blockIdx.x; u < 256; u += gridDim.x) {
    const int b = u >> 6, h = (u >> 3) & 7, pq = u & 7;
    if (fast) { for (int hh = 0; hh < 2; ++hh) attn_unit<true>(p, lds, b, h, hh ? pq : 15 - pq, lam); }
    else { for (int hh = 0; hh < 2; ++hh) attn_unit<false>(p, lds, b, h, hh ? pq : 15 - pq, lam); }
  }
}

__device__ __forceinline__ void ph_outproj(const Params& p, LAS char* lds) {
  unsigned bo[2]; b_offsets<true>(bo);
  for (int u = blockIdx.x; u < 32 * 8; u += gridDim.x) {
    const int pm = u & 31, pn = u >> 5;
    unsigned ao[2][2];
#pragma unroll
    for (int h = 0; h < 2; ++h)
#pragma unroll
      for (int i = 0; i < 2; ++i) { int R, C; stage_rc(otid() * 16 + i * 8192, R, C); ao[h][i] = (unsigned)((pm * 256 + h * 128 + R) * KDIM + C) * 2u; }
    EpiProj E{p.hn, pm, pn, DM};
    gemm_unit(lds, mk_rsrc(p.mix), ao, mk_rsrc(p.wt_out + (size_t)(pn * 256) * KDIM), mk_rsrc(p.wt_out + (size_t)(pn * 256 + 128) * KDIM), bo, E);
    __syncthreads();
  }
}

__device__ __forceinline__ void ph_router(const Params& p, LAS char* lds) {
  const int tid = otid(), kq = tid >> 6, lane = tid & 63, fr = lane & 15, fq = lane >> 4;
  LAS float* ssq = (LAS float*)lds;
  LAS float* part = (LAS float*)(lds + 1024);
  LAS float* nwS = (LAS float*)(lds + 40960);
  *(LAS f32x4*)(nwS + tid * 4) = *(const f32x4*)(p.ffn_norm_w + tid * 4);
  __syncthreads();
  for (int task = blockIdx.x; task < T_TOK / 32; task += gridDim.x) {
    f32x4 ha[2][8], hb[2][8];
#pragma unroll
    for (int rt = 0; rt < 2; ++rt) { const size_t ro = (size_t)(task * 32 + rt * 16 + fr) * DM + kq * 256 + fq * 8; const float* xr = p.x + ro; const bf16_t* ar = p.hn + ro;
#pragma unroll
      for (int ks = 0; ks < 8; ++ks) { const u32x4 av = *(const u32x4*)(ar + ks * 32);
        ha[rt][ks] = *(const f32x4*)(xr + ks * 32) + (f32x4){bflo(av.x), bfhi(av.x), bflo(av.y), bfhi(av.y)}; hb[rt][ks] = *(const f32x4*)(xr + ks * 32 + 4) + (f32x4){bflo(av.z), bfhi(av.z), bflo(av.w), bfhi(av.w)}; }
      __builtin_amdgcn_sched_barrier(0); }
#pragma unroll
    for (int rt = 0; rt < 2; ++rt) { float ss = 0.f;
#pragma unroll
      for (int ks = 0; ks < 8; ++ks) { const f32x4 a = ha[rt][ks], c = hb[rt][ks]; ss += a[0] * a[0] + a[1] * a[1] + a[2] * a[2] + a[3] * a[3] + c[0] * c[0] + c[1] * c[1] + c[2] * c[2] + c[3] * c[3]; }
      ss += __shfl_xor(ss, 16); ss += __shfl_xor(ss, 32);
      if (fq == 0) ssq[(rt * 8 + kq) * 16 + fr] = ss; }
    __syncthreads();
    float rstd[2];
#pragma unroll
    for (int rt = 0; rt < 2; ++rt) { float tot = 0.f;
#pragma unroll
      for (int q = 0; q < 8; ++q) tot += ssq[(rt * 8 + q) * 16 + fr];
      rstd[rt] = rsqrtf(tot * (1.0f / 2048.0f) + 1e-6f); }
    f32x4 acc[2][2];
#pragma unroll
    for (int rt = 0; rt < 2; ++rt) { acc[rt][0] = (f32x4){0.f, 0.f, 0.f, 0.f}; acc[rt][1] = (f32x4){0.f, 0.f, 0.f, 0.f}; }
    const bf16_t* wh0 = p.wr_hi + fr * 2048 + kq * 256 + fq * 8; const bf16_t* wl0 = p.wr_lo + fr * 2048 + kq * 256 + fq * 8;
    const LAS float* nwp = nwS + kq * 256 + fq * 8;
#pragma unroll
    for (int ks = 0; ks < 8; ++ks) {
      const f32x4 wa = *(const LAS f32x4*)(nwp + ks * 32), wc = *(const LAS f32x4*)(nwp + ks * 32 + 4);
      const bf16x8 bh0 = *(const bf16x8*)(wh0 + ks * 32), bh1 = *(const bf16x8*)(wh0 + 16 * 2048 + ks * 32), bl0 = *(const bf16x8*)(wl0 + ks * 32), bl1 = *(const bf16x8*)(wl0 + 16 * 2048 + ks * 32);
#pragma unroll
      for (int rt = 0; rt < 2; ++rt) {
        const f32x4 a = ha[rt][ks], c = hb[rt][ks]; const float rs = rstd[rt];
        float t[8] = {a[0] * rs * wa[0], a[1] * rs * wa[1], a[2] * rs * wa[2], a[3] * rs * wa[3], c[0] * rs * wc[0], c[1] * rs * wc[1], c[2] * rs * wc[2], c[3] * rs * wc[3]};
        u32x4 hi4, lo4;
        hi4.x = cvt_pk_bf16(t[0], t[1]); hi4.y = cvt_pk_bf16(t[2], t[3]); hi4.z = cvt_pk_bf16(t[4], t[5]); hi4.w = cvt_pk_bf16(t[6], t[7]);
        lo4.x = cvt_pk_bf16(t[0] - bflo(hi4.x), t[1] - bfhi(hi4.x)); lo4.y = cvt_pk_bf16(t[2] - bflo(hi4.y), t[3] - bfhi(hi4.y));
        lo4.z = cvt_pk_bf16(t[4] - bflo(hi4.z), t[5] - bfhi(hi4.z)); lo4.w = cvt_pk_bf16(t[6] - bflo(hi4.w), t[7] - bfhi(hi4.w));
        *(u32x4*)(p.tb + (size_t)(task * 32 + rt * 16 + fr) * DM + kq * 256 + fq * 8 + ks * 32) = hi4;
        const bf16x8 ah = *reinterpret_cast<bf16x8*>(&hi4), al = *reinterpret_cast<bf16x8*>(&lo4);
        acc[rt][0] = __builtin_amdgcn_mfma_f32_16x16x32_bf16(ah, bh0, acc[rt][0], 0, 0, 0); acc[rt][0] = __builtin_amdgcn_mfma_f32_16x16x32_bf16(ah, bl0, acc[rt][0], 0, 0, 0); acc[rt][0] = __builtin_amdgcn_mfma_f32_16x16x32_bf16(al, bh0, acc[rt][0], 0, 0, 0);
        acc[rt][1] = __builtin_amdgcn_mfma_f32_16x16x32_bf16(ah, bh1, acc[rt][1], 0, 0, 0); acc[rt][1] = __builtin_amdgcn_mfma_f32_16x16x32_bf16(ah, bl1, acc[rt][1], 0, 0, 0); acc[rt][1] = __builtin_amdgcn_mfma_f32_16x16x32_bf16(al, bh1, acc[rt][1], 0, 0, 0);
      }
    }
#pragma unroll
    for (int rt = 0; rt < 2; ++rt) { LAS float* pw_ = part + (rt * 8 + kq) * (16 * 33);
#pragma unroll
      for (int r = 0; r < 4; ++r) { pw_[(fq * 4 + r) * 33 + fr] = acc[rt][0][r]; pw_[(fq * 4 + r) * 33 + 16 + fr] = acc[rt][1][r]; } }
    __syncthreads();
    if (kq < 2 && lane < 16) { const int rt = kq;
      float v[32]; const LAS float* pr_ = part + (rt * 8) * (16 * 33) + lane * 33;
#pragma unroll
      for (int e = 0; e < 32; ++e) { float sacc = p.router_b[e];
#pragma unroll
        for (int q = 0; q < 8; ++q) sacc += pr_[q * 16 * 33 + e];
        v[e] = sacc; }
      float tv[4]; int ti[4];
#pragma unroll
      for (int k = 0; k < 4; ++k) { float best = -3.0e38f; int bi = 0;
#pragma unroll
        for (int e = 0; e < 32; ++e) { if (v[e] > best) { best = v[e]; bi = e; } }
        tv[k] = best; ti[k] = bi;
#pragma unroll
        for (int e = 0; e < 32; ++e) v[e] = (e == bi) ? -3.0e38f : v[e]; }
      const float e1 = expf(tv[1] - tv[0]), e2 = expf(tv[2] - tv[0]), e3 = expf(tv[3] - tv[0]); const float inv = 1.0f / (1.0f + e1 + e2 + e3);
      const float wk[4] = {inv, e1 * inv, e2 * inv, e3 * inv};
      const int tok = task * 32 + rt * 16 + lane;
#pragma unroll
      for (int k = 0; k < 4; ++k) { const unsigned slot = __hip_atomic_fetch_add(p.cnt + ti[k], 1u, __ATOMIC_RELAXED, __HIP_MEMORY_SCOPE_AGENT);
        p.list[ti[k] * CAP + (int)slot] = tok * 4 + k; p.pw[tok * 4 + k] = wk[k]; }
    }
    __syncthreads();
  }
}

struct MoeTab { int cnt[32]; int base[33]; };
template <int NPL> __device__ __forceinline__ void moe_table(const Params& p, LAS MoeTab* tb) {
  if (otid() < 32) tb->cnt[otid()] = (int)__hip_atomic_load(p.cnt + otid(), __ATOMIC_RELAXED, __HIP_MEMORY_SCOPE_AGENT);
  __syncthreads();
  if (otid() == 0) { int s = 0; for (int e = 0; e < 32; ++e) { tb->base[e] = s; s += ((tb->cnt[e] + 255) >> 8) * NPL; } tb->base[32] = s; }
  __syncthreads();
}
struct EpiAct { rsrc_t RO; const LAS float* biasS; const LAS int* pairS; int pn;
  __device__ __forceinline__ void init(f32x4 (&acc)[2][2][4][2], int wc, int fq) const {
    const int cl = wc * 32 + 4 * fq;
#pragma unroll
    for (int bj = 0; bj < 2; ++bj)
#pragma unroll
      for (int n = 0; n < 2; ++n) { const f32x4 bv = *(const LAS f32x4*)(biasS + bj * 128 + cl + n * 16);
#pragma unroll
        for (int ai = 0; ai < 2; ++ai)
#pragma unroll
          for (int m = 0; m < 4; ++m) acc[ai][bj][m][n] = bv; }
  }
  template <int AI, int M0, int M1> __device__ __forceinline__ void part(const f32x4 (&acc)[2][2][4][2], int wr, int wc, int fr, int fq) const {
    const int odd = fq & 1, cs = pn * 128 + wc * 32 + (odd ? 16 : 0) + 8 * (fq >> 1);
    { constexpr int ai = AI;
#pragma unroll
      for (int m = M0; m < M1; ++m) { const int pr = pairS[ai * 128 + wr * 64 + m * 16 + fr];
        if (!__any(pr >= 0)) continue;
        u32x2 wq[2];
#pragma unroll
        for (int n = 0; n < 2; ++n) {
          f32x4 g = acc[ai][0][m][n], uu = acc[ai][1][m][n], e;
#pragma unroll
          for (int j = 0; j < 4; ++j) { g[j] = __builtin_amdgcn_fmed3f(g[j], -__builtin_inff(), 7.0f); uu[j] = __builtin_amdgcn_fmed3f(uu[j], -7.0f, 7.0f); }
          const f32x4 ta = g * (-1.702f * 1.4426950408889634f);
#pragma unroll
          for (int j = 0; j < 4; ++j) e[j] = __builtin_amdgcn_exp2f(ta[j]);
          e = e + 1.0f;
#pragma unroll
          for (int j = 0; j < 4; ++j) e[j] = __builtin_amdgcn_rcpf(e[j]);
          const f32x4 r4 = (uu + 1.0f) * g * e;
          wq[n].x = cvt_pk_bf16(r4[0], r4[1]); wq[n].y = cvt_pk_bf16(r4[2], r4[3]); }
        u32x4 w; quad_pair16(wq[0], wq[1], odd, w);
        if (pr >= 0) __builtin_amdgcn_raw_buffer_store_b128(w, RO, (unsigned)(pr * DM + cs) * 2u, 0, 16); } }
  } };
struct EpiY { bf16_t* O; const LAS float* biasS; const LAS float* pwS; const LAS int* pairS; int pn;
  __device__ __forceinline__ void init(f32x4 (&acc)[2][2][4][2], int wc, int fq) const {
    const int cl = wc * 32 + 4 * fq;
#pragma unroll
    for (int bj = 0; bj < 2; ++bj)
#pragma unroll
      for (int n = 0; n < 2; ++n) { const f32x4 bv = *(const LAS f32x4*)(biasS + cl + bj * 128 + n * 16);
#pragma unroll
        for (int ai = 0; ai < 2; ++ai)
#pragma unroll
          for (int m = 0; m < 4; ++m) acc[ai][bj][m][n] = bv; }
  }
  template <int AI, int M0, int M1> __device__ __forceinline__ void part(const f32x4 (&acc)[2][2][4][2], int wr, int wc, int fr, int fq) const {
    const int odd = fq & 1, cs = pn * 256 + wc * 32 + (odd ? 16 : 0) + 8 * (fq >> 1);
    { constexpr int ai = AI;
#pragma unroll
      for (int m = M0; m < M1; ++m) { const int rl = ai * 128 + wr * 64 + m * 16 + fr; const int pr = pairS[rl]; const float wgt = pwS[rl];
        if (!__any(pr >= 0)) continue;
#pragma unroll
        for (int bj = 0; bj < 2; ++bj) { u32x2 wq[2];
#pragma unroll
          for (int n = 0; n < 2; ++n) { const f32x4 v0 = acc[ai][bj][m][n] * wgt; wq[n].x = cvt_pk_bf16(v0[0], v0[1]); wq[n].y = cvt_pk_bf16(v0[2], v0[3]); }
          u32x4 w; quad_pair16(wq[0], wq[1], odd, w);
          if (pr >= 0) *(u32x4*)(O + (size_t)pr * DM + cs + bj * 128) = w; } } }
  } };
__device__ __forceinline__ void ph_moe_all(const Params& p, LAS char* lds) {
  LAS MoeTab* tb = (LAS MoeTab*)(lds + LDS_MISC); LAS int* pairS = (LAS int*)(lds + LDS_PAIR); LAS int* qS = (LAS int*)(lds + LDS_MISC + 512);
  moe_table<1>(p, tb);
  const int Mt = __builtin_amdgcn_readfirstlane(tb->base[32]), total = 3 * Mt;
  const int xl = blockIdx.x & 7;
  unsigned* qh = p.bar + CW_QHEAD + 16 * xl; unsigned* tmo = p.bar + CW_TMO;
  if (otid() == 0) qS[0] = (int)__hip_atomic_fetch_add(qh, 1u, __ATOMIC_RELAXED, __HIP_MEMORY_SCOPE_AGENT);
  __syncthreads();
  for (;;) {
    const int ent = __builtin_amdgcn_readfirstlane(qS[0]);
    if (ent >= total) break;
    unsigned nxt = 0u;
    if (otid() == 0) nxt = __hip_atomic_fetch_add(qh, 1u, __ATOMIC_RELAXED, __HIP_MEMORY_SCOPE_AGENT);
    const int which = ent >= 2 * Mt ? 1 : 0, idx0 = which ? ent - 2 * Mt : ent, npl = which ? 1 : 2;
    const int lq = otid() & 31;
    const unsigned long long bal = __ballot(idx0 >= tb->base[lq] * npl);
    const int e = __builtin_amdgcn_readfirstlane(__popcll(bal & 0xffffffffull) - 1);
    const int ce = __builtin_amdgcn_readfirstlane(tb->cnt[e]), mte = (ce + 255) >> 8, idx = idx0 - __builtin_amdgcn_readfirstlane(tb->base[e]) * npl, pnl = idx / mte, mt = idx - pnl * mte, pn = xl + 8 * pnl;
    unsigned* dn = p.bar + CW_DONE + 16 * (e * 32 + mt);
    if (which && otid() < 64) {
      unsigned sp = 0;
      while (__builtin_amdgcn_readfirstlane(__hip_atomic_load(dn, __ATOMIC_RELAXED, __HIP_MEMORY_SCOPE_AGENT)) < 16u) { __builtin_amdgcn_s_sleep(2);
        if ((++sp & 255u) == 0u) { if (__hip_atomic_load(tmo, __ATOMIC_RELAXED, __HIP_MEMORY_SCOPE_AGENT)) break; if (sp > (1u << 20)) { atomicAdd(tmo, 1u); break; } } }
      __builtin_amdgcn_fence(__ATOMIC_ACQUIRE, "agent");
      asm volatile("s_waitcnt vmcnt(0)" ::: "memory");
    }
    LAS float* biasS = (LAS float*)(lds + LDS_MISC + 1024); LAS float* pwS = (LAS float*)(lds + LDS_MISC + 2048);
    if (otid() < 256) { const int r = mt * 256 + otid(); const int pr = (r < ce) ? p.list[e * CAP + r] : -1; pairS[otid()] = pr; if (which) pwS[otid()] = pr >= 0 ? p.pw[pr] : 0.f; }
    else { const int c = otid() - 256;
      biasS[c] = which ? p.bd[e * 2048 + pn * 256 + c] : (c < 128 ? p.bg[e * 2048 + pn * 128 + c] : p.bu[e * 2048 + pn * 128 + c - 128]); }
    __syncthreads();
    unsigned ao[2][2];
#pragma unroll
    for (int h = 0; h < 2; ++h)
#pragma unroll
      for (int i = 0; i < 2; ++i) { int R, C; stage_rc(otid() * 16 + i * 8192, R, C); const int pr = pairS[h * 128 + R];
        ao[h][i] = pr < 0 ? 0x80000000u : (unsigned)((which ? pr : (pr >> 2)) * KDIM + C) * 2u; }
    const size_t eo = (size_t)e * 2048 * 2048;
    const bool half = (ce - mt * 256) <= 128;
    if (which == 0) { EpiAct E{mk_rsrc(p.act), biasS, pairS, pn};
      if (half) gemm_unit_f32b<true>(lds, mk_rsrc(p.tb), ao, mk_rsrc(p.wg + eo + pn * 128), mk_rsrc(p.wu + eo + pn * 128), E);
      else gemm_unit_f32b<false>(lds, mk_rsrc(p.tb), ao, mk_rsrc(p.wg + eo + pn * 128), mk_rsrc(p.wu + eo + pn * 128), E); }
    else { EpiY E{p.y, biasS, pwS, pairS, pn};
      if (half) gemm_unit_f32b<true>(lds, mk_rsrc(p.act), ao, mk_rsrc(p.wd + eo + pn * 256), mk_rsrc(p.wd + eo + pn * 256 + 128), E);
      else gemm_unit_f32b<false>(lds, mk_rsrc(p.act), ao, mk_rsrc(p.wd + eo + pn * 256), mk_rsrc(p.wd + eo + pn * 256 + 128), E); }
    if (which == 0) asm volatile("s_waitcnt vmcnt(0)" ::: "memory");
    __syncthreads();
    if (otid() == 0) { if (which == 0) __hip_atomic_fetch_add(dn, 1u, __ATOMIC_RELAXED, __HIP_MEMORY_SCOPE_AGENT); qS[0] = (int)nxt; }
    __syncthreads();
  }
}

__device__ __forceinline__ void ph_combine(const Params& p) {
  for (int g0 = blockIdx.x * 512 + otid(); g0 < T_TOK * 256; g0 += gridDim.x * 1024) {
    f32x4 a[2], b[2]; u32x4 av[2], y[2][4];
#pragma unroll
    for (int z = 0; z < 2; ++z) { int g = g0 + z * gridDim.x * 512; g = g < T_TOK * 256 ? g : g0; const size_t eo = (size_t)g * 8; const int t = g >> 8, c8 = (g & 255) * 8;
      a[z] = *(const f32x4*)(p.x + eo); b[z] = *(const f32x4*)(p.x + eo + 4); av[z] = *(const u32x4*)(p.hn + eo);
#pragma unroll
      for (int k = 0; k < 4; ++k) y[z][k] = *(const u32x4*)(p.y + (size_t)(t * 4 + k) * DM + c8); }
#pragma unroll
    for (int z = 0; z < 2; ++z) { int g = g0 + z * gridDim.x * 512; g = g < T_TOK * 256 ? g : g0; f32x4 aa = a[z], bb = b[z];
      aa[0] += bflo(av[z].x); aa[1] += bfhi(av[z].x); aa[2] += bflo(av[z].y); aa[3] += bfhi(av[z].y); bb[0] += bflo(av[z].z); bb[1] += bfhi(av[z].z); bb[2] += bflo(av[z].w); bb[3] += bfhi(av[z].w);
#pragma unroll
      for (int k = 0; k < 4; ++k) { const u32x4 yy = y[z][k];
        aa[0] += bflo(yy.x); aa[1] += bfhi(yy.x); aa[2] += bflo(yy.y); aa[3] += bfhi(yy.y); bb[0] += bflo(yy.z); bb[1] += bfhi(yy.z); bb[2] += bflo(yy.w); bb[3] += bfhi(yy.w); }
      float* op = p.out + (size_t)g * 8; *(f32x4*)op = aa; *(f32x4*)(op + 4) = bb; }
  }
}

template <int PH> __device__ __forceinline__ void run_phase(const Params& p, LAS char* lds) {
  if constexpr (PH == 0) { ph_norm_gd(p, lds); ph_convert(p, lds); }
  if constexpr (PH == 1) { ph_inproj(p, lds); ph_gdown(p, lds); }
  if constexpr (PH == 2) { ph_gla1(p, lds); if (PROBE & 128) ph_gla1(p, lds); }
  if constexpr (PH == 3) ph_gla_scan(p, lds);
  if constexpr (PH == 4) { ph_gla3(p, lds); if (PROBE & 256) ph_gla3(p, lds); ph_attn(p, lds); if (PROBE & 512) ph_attn(p, lds); }
  if constexpr (PH == 5) ph_outproj(p, lds);
  if constexpr (PH == 6) ph_router(p, lds);
  if constexpr (PH == 7) ph_moe_all(p, lds);
  if constexpr (PH == 9) ph_combine(p);
}
extern __shared__ __attribute__((aligned(16))) char smem_raw[];
#if !FUSED
template <int PH> __global__ void __launch_bounds__(512, 2) k_phase(Params p) {
  LAS char* lds = (LAS char*)smem_raw;
  run_phase<PH>(p, lds);
}
#else
typedef const __attribute__((address_space(4))) Params* KArgP;
__device__ __forceinline__ Params load_params(KArgP k) { Params q; q.x = k->x; q.attn_norm_w = k->attn_norm_w; q.w_in = k->w_in; q.q_norm_w = k->q_norm_w; q.k_norm_w = k->k_norm_w; q.lq1 = k->lq1; q.lk1 = k->lk1; q.lq2 = k->lq2; q.lk2 = k->lk2; q.subln_w = k->subln_w; q.gate_up_w = k->gate_up_w; q.gate_up_b = k->gate_up_b; q.gla_norm_w = k->gla_norm_w; q.w_out = k->w_out; q.ffn_norm_w = k->ffn_norm_w; q.router_w = k->router_w; q.router_b = k->router_b; q.wg = k->wg; q.bg = k->bg; q.wu = k->wu; q.bu = k->bu; q.wd = k->wd; q.bd = k->bd; q.out = k->out; q.bar = k->bar; q.cnt = k->cnt; q.wt_in = k->wt_in; q.wt_out = k->wt_out; q.wgd_hi = k->wgd_hi; q.wgd_lo = k->wgd_lo; q.hn = k->hn; q.proj = k->proj; q.mix = k->mix; q.qtil = k->qtil; q.st = k->st; q.tb = k->tb; q.wr_hi = k->wr_hi; q.wr_lo = k->wr_lo; q.act = k->act; q.y = k->y; q.gd = k->gd; q.decay = k->decay; q.pw = k->pw; q.oib = k->oib; q.Ub = k->Ub; q.list = k->list; return q; }
#define RUN(PHX) do { KArgP kp_ = kp0; asm volatile("" : "+s"(kp_)); const Params q_ = load_params(kp_); run_phase<PHX>(q_, lds); } while (0)
__global__ void __launch_bounds__(512, 2) k_fused(Params p) {
  LAS char* lds = (LAS char*)smem_raw;
  const KArgP kp0 = (KArgP)__builtin_amdgcn_kernarg_segment_ptr();
  volatile LAS unsigned* xbw = (volatile LAS unsigned*)(lds + LDS_BYTES - 16);
  if (threadIdx.x == 0) { xbw[0] = 0u; xbw[1] = 0u; xbw[2] = 0u; xbw[3] = 0u; }
  __syncthreads();
  XcdBarrier bar = xcd_barrier_post(p.bar, xbw);
#define DUP(PHX, MASK) if (PROBE & (MASK)) { RUN(PHX); xcd_barrier(bar); }
  RUN(0); xcd_barrier(bar); DUP(0, 1)
  RUN(1); xcd_barrier(bar); DUP(1, 2)
  RUN(2); xcd_barrier(bar);
  RUN(3); xcd_barrier(bar); DUP(3, 4)
  RUN(4); xcd_barrier(bar); DUP(4, 8)
  RUN(5); xcd_barrier(bar); DUP(5, 16)
  RUN(6); xcd_barrier(bar);
  RUN(7); xcd_barrier(bar);
  RUN(9);
#undef DUP
#undef RUN
}
#endif

static size_t carve(size_t& off, size_t bytes) { const size_t o = off; off = (off + bytes + 255) & ~(size_t)255; return o; }

#if !FUSED
template <int PH> static void launch_phase(const Params& p, int grid, hipStream_t s) {
  static bool set = false;
  if (!set) { (void)hipFuncSetAttribute((const void*)k_phase<PH>, hipFuncAttributeMaxDynamicSharedMemorySize, LDS_BYTES); set = true; }
  hipLaunchKernelGGL(k_phase<PH>, dim3(grid), dim3(512), LDS_BYTES, s, p);
}
#endif

extern "C" void kernel_launch(void* const* d_in, const int* in_sizes, int n_in, void* d_out, int out_size, void* d_ws, size_t ws_size, hipStream_t stream) {
  (void)in_sizes; (void)n_in; (void)out_size;
  Params p{};
  const float* const* in = (const float* const*)d_in;
  p.x = in[0]; p.attn_norm_w = in[1]; p.w_in = in[2]; p.q_norm_w = in[3]; p.k_norm_w = in[4]; p.lq1 = in[5]; p.lk1 = in[6]; p.lq2 = in[7]; p.lk2 = in[8];
  p.subln_w = in[9]; p.gate_up_w = in[10]; p.gate_up_b = in[11]; p.gla_norm_w = in[12]; p.w_out = in[13]; p.ffn_norm_w = in[14]; p.router_w = in[15]; p.router_b = in[16];
  p.wg = in[17]; p.bg = in[18]; p.wu = in[19]; p.bu = in[20]; p.wd = in[21]; p.bd = in[22];
  p.out = (float*)d_out;
  char* ws = (char*)d_ws; size_t off = 0;
  const size_t ctl = carve(off, CTL_BYTES);
  p.bar = (unsigned*)(ws + ctl); p.cnt = p.bar + CW_CNT;
  const size_t WSZ = (size_t)2048 * 2048 * 2;
  p.wt_in = (bf16_t*)(ws + carve(off, (size_t)NP * 2048 * 2));
  p.wt_out = (bf16_t*)(ws + carve(off, WSZ));
  p.wgd_hi = (bf16_t*)(ws + carve(off, 16 * 2048 * 2)); p.wgd_lo = (bf16_t*)(ws + carve(off, 16 * 2048 * 2));
  p.hn = (bf16_t*)(ws + carve(off, (size_t)T_TOK * DM * 2));
  p.proj = (bf16_t*)(ws + carve(off, (size_t)T_TOK * NP * 2));
  p.mix = (bf16_t*)(ws + carve(off, (size_t)T_TOK * DM * 2));
  p.qtil = (bf16_t*)(ws + carve(off, (size_t)512 * 64 * 128 * 2));
  p.st = (bf16_t*)(ws + carve(off, (size_t)512 * 256 * 128 * 2));
  p.tb = (bf16_t*)(ws + carve(off, (size_t)T_TOK * DM * 2));
  p.wr_hi = (bf16_t*)(ws + carve(off, 32 * 2048 * 2)); p.wr_lo = (bf16_t*)(ws + carve(off, 32 * 2048 * 2));
  p.act = (bf16_t*)(ws + carve(off, (size_t)T_TOK * 4 * DM * 2));
  p.y = (bf16_t*)(ws + carve(off, (size_t)T_TOK * 4 * DM * 2));
  p.gd = (float*)(ws + carve(off, (size_t)T_TOK * 16 * 4));
  p.oib = (bf16_t*)(ws + carve(off, (size_t)512 * 64 * 256 * 2));
  p.Ub = (bf16_t*)(ws + carve(off, (size_t)512 * 256 * 128 * 2));
  p.decay = (float*)(ws + carve(off, 512 * 128 * 4));
  p.pw = (float*)(ws + carve(off, (size_t)T_TOK * 4 * 4));
  p.list = (int*)(ws + carve(off, (size_t)NEXP * CAP * 4));
  if (off > ws_size) { fprintf(stderr, "kernel_launch: workspace too small: need %zu have %zu\n", off, ws_size); return; }
  static int grid = 0;
  if (!grid) { int dev = 0, cus = 0; (void)hipGetDevice(&dev); (void)hipDeviceGetAttribute(&cus, hipDeviceAttributeMultiprocessorCount, dev); grid = cus > 0 ? cus : 256; }
  (void)hipMemsetAsync(ws + ctl, 0, CTL_BYTES, stream);
#if !FUSED
  launch_phase<0>(p, grid, stream); launch_phase<1>(p, grid, stream); launch_phase<2>(p, grid, stream); launch_phase<3>(p, grid, stream); launch_phase<4>(p, grid, stream);
  launch_phase<5>(p, grid, stream); launch_phase<6>(p, grid, stream); launch_phase<7>(p, grid, stream); launch_phase<8>(p, grid, stream); launch_phase<9>(p, grid, stream);
#else
  static bool set = false;
  if (!set) {
    (void)hipFuncSetAttribute((const void*)k_fused, hipFuncAttributeMaxDynamicSharedMemorySize, LDS_BYTES);
    int per_cu = 0;
    if (hipOccupancyMaxActiveBlocksPerMultiprocessor(&per_cu, (const void*)k_fused, 512, LDS_BYTES) != hipSuccess || per_cu < 1)
      fprintf(stderr, "kernel_launch: occupancy query reports %d workgroups per CU\n", per_cu);
    set = true;
  }
  hipLaunchKernelGGL(k_fused, dim3(grid), dim3(512), LDS_BYTES, stream, p);
#endif
  const hipError_t le = hipPeekAtLastError();
  if (le != hipSuccess) fprintf(stderr, "kernel_launch: launch failed: %s\n", hipGetErrorName(le));
}
```
